# Optimizing an MI355X kernel written in HIP

```python
import math
import jax, jax.numpy as jnp
from jax import lax
import numpy as np


D_MODEL = 2048
BATCH = 4
SEQ = 4096
DEPTH = 1

GRID_W = 64
CTX_LEN = 256
EPS = 1e-6
NEG_INF = -1e30
ROPE_THETA = 10000.0

DIFF_DH = 64
DIFF_DV = 2 * DIFF_DH
DIFF_HEADS = D_MODEL // (2 * DIFF_DV)
DIFF_WIDTH = DIFF_HEADS * DIFF_DV
Q_BLOCK = 128

SWA_DH = 64
SWA_HEADS = D_MODEL // (2 * SWA_DH)
SWA_KV = 4
SWA_GROUP = SWA_HEADS // SWA_KV
SWA_WIDTH = SWA_HEADS * SWA_DH
WINDOW = 128
BAND_BLOCK = 128

MIX_WIDTH = DIFF_WIDTH + SWA_WIDTH
ROPE_PAIRS = 16

W_DQ = DIFF_HEADS * 2 * DIFF_DH
W_DK = DIFF_HEADS * 2 * DIFF_DH
W_DV = DIFF_WIDTH
W_SQ = SWA_HEADS * SWA_DH
W_SK = SWA_KV * SWA_DH
W_SV = SWA_KV * SWA_DH
PROJ_OFFSETS = (W_DQ, W_DQ + W_DK, W_DQ + W_DK + W_DV, W_DQ + W_DK + W_DV + W_SQ,
                W_DQ + W_DK + W_DV + W_SQ + W_SK)
PROJ_WIDTH = W_DQ + W_DK + W_DV + W_SQ + W_SK + W_SV

PEER_HEADS = 8
PEER_TOPK = 16
N_KEYS = 128
N_EXPERTS = N_KEYS * N_KEYS
PEER_DQ = 256
PEER_DHALF = PEER_DQ // 2
TOKEN_CHUNK = 128

kernel_name = 'hymba_diffattn_swa_peer_dit_block'


def rms_norm(x, g):
    xf = x.astype(jnp.float32)
    y = xf * lax.rsqrt(jnp.mean(xf * xf, axis=-1, keepdims=True) + EPS)
    return y.astype(x.dtype) * g


def modulate(h, shift, scale):
    return h * (1 + scale) + shift


def head_rms(x, gain):
    xf = x.astype(jnp.float32)
    y = xf * lax.rsqrt(jnp.mean(xf * xf, axis=-1, keepdims=True) + EPS)
    return y.astype(x.dtype).reshape(x.shape[:2] + (-1,)) * gain


def axial_rope_tables(rows, dtype):
    row = jnp.repeat(jnp.arange(rows, dtype=jnp.float32), GRID_W)
    col = jnp.tile(jnp.arange(GRID_W, dtype=jnp.float32), rows)
    freqs = ROPE_THETA ** (-jnp.arange(ROPE_PAIRS, dtype=jnp.float32) / ROPE_PAIRS)
    ang = jnp.stack([row[:, None] * freqs, col[:, None] * freqs], axis=1)
    return jnp.cos(ang).astype(dtype), jnp.sin(ang).astype(dtype)


def apply_rope(x, cos, sin):
    xr = x.reshape(x.shape[:-1] + (2, 2, ROPE_PAIRS))
    x1, x2 = xr[..., 0, :], xr[..., 1, :]
    shape = (cos.shape[0],) + (1,) * (x.ndim - 3) + (2, ROPE_PAIRS)
    cs, sn = cos.reshape(shape), sin.reshape(shape)
    out = jnp.stack([x1 * cs - x2 * sn, x2 * cs + x1 * sn], axis=-2)
    return out.reshape(x.shape)


def split_heads(p):
    B, T = p.shape[:2]
    dq, dk, dv, sq, sk, sv = jnp.split(p, list(PROJ_OFFSETS), axis=-1)
    return (dq.reshape(B, T, DIFF_HEADS, 2, DIFF_DH), dk.reshape(B, T, DIFF_HEADS, 2, DIFF_DH),
            dv.reshape(B, T, DIFF_HEADS, DIFF_DV), sq.reshape(B, T, SWA_HEADS, SWA_DH),
            sk.reshape(B, T, SWA_KV, SWA_DH), sv.reshape(B, T, SWA_KV, SWA_DH))


def diff_attend(q, k, v, lam):
    s = jnp.einsum('bqhid,bkhid->bhiqk', q, k).astype(jnp.float32) * (DIFF_DH ** -0.5)
    a = jax.nn.softmax(s, axis=-1)
    a = a[:, :, 0] - lam * a[:, :, 1]
    return jnp.einsum('bhqk,bkhe->bqhe', a.astype(v.dtype), v)


def diff_latent(q, k, v, kc, vc, lam):
    B, S = q.shape[:2]
    nq = S // Q_BLOCK
    k_all = jnp.concatenate([kc, k], axis=1)
    v_all = jnp.concatenate([vc, v], axis=1)
    qb = jnp.moveaxis(q.reshape((B, nq, Q_BLOCK) + q.shape[2:]), 1, 0)
    o = lax.map(lambda qblk: diff_attend(qblk, k_all, v_all, lam), qb)
    return jnp.moveaxis(o, 0, 1).reshape(B, S, DIFF_HEADS, DIFF_DV)


def swa_latent(q, k, v, kc, vc, sink):
    B, S = q.shape[:2]
    nb = S // BAND_BLOCK
    scale = SWA_DH ** -0.5
    qb = q.reshape(B, nb, BAND_BLOCK, SWA_KV, SWA_GROUP, SWA_DH)

    def pad_blocks(t):
        t = jnp.pad(t, ((0, 0), (BAND_BLOCK, BAND_BLOCK), (0, 0), (0, 0)))
        return t.reshape(B, nb + 2, BAND_BLOCK, SWA_KV, SWA_DH)

    def band(t):
        return jnp.concatenate([t[:, :-2], t[:, 1:-1], t[:, 2:]], axis=2)

    kb, vb = band(pad_blocks(k)), band(pad_blocks(v))
    qi = jnp.arange(BAND_BLOCK)[:, None]
    ki = jnp.arange(3 * BAND_BLOCK)[None, :]
    rel_ok = jnp.abs(qi + BAND_BLOCK - ki) <= WINDOW
    sink_l = sink.reshape(SWA_KV, SWA_GROUP).astype(jnp.float32)
    n_band = 3 * BAND_BLOCK

    def one_block(args):
        qn, kn, vn, n = args
        kpos = (n - 1) * BAND_BLOCK + ki
        ok = rel_ok & (kpos >= 0) & (kpos < S)
        s_band = jnp.einsum('bqhgd,bkhd->bhgqk', qn, kn).astype(jnp.float32) * scale
        s_band = jnp.where(ok, s_band, NEG_INF)
        s_ctx = jnp.einsum('bqhgd,bkhd->bhgqk', qn, kc).astype(jnp.float32) * scale
        s_sink = jnp.broadcast_to(sink_l[None, :, :, None, None], s_band.shape[:-1] + (1,))
        p = jax.nn.softmax(jnp.concatenate([s_sink, s_band, s_ctx], axis=-1), axis=-1)
        pb = p[..., 1:1 + n_band].astype(vn.dtype)
        pc = p[..., 1 + n_band:].astype(vc.dtype)
        return (jnp.einsum('bhgqk,bkhd->bqhgd', pb, vn)
                + jnp.einsum('bhgqk,bkhd->bqhgd', pc, vc))

    xs = (jnp.moveaxis(qb, 1, 0), jnp.moveaxis(kb, 1, 0), jnp.moveaxis(vb, 1, 0),
          jnp.arange(nb, dtype=jnp.int32))
    o = lax.map(one_block, xs)
    return jnp.moveaxis(o, 0, 1).reshape(B, S, SWA_HEADS, SWA_DH)


def swa_context(qc, kc, vc, sink):
    B, L = qc.shape[:2]
    qg = qc.reshape(B, L, SWA_KV, SWA_GROUP, SWA_DH)
    s = jnp.einsum('bqhgd,bkhd->bhgqk', qg, kc).astype(jnp.float32) * (SWA_DH ** -0.5)
    sink_l = sink.reshape(SWA_KV, SWA_GROUP).astype(jnp.float32)
    s_sink = jnp.broadcast_to(sink_l[None, :, :, None, None], s.shape[:-1] + (1,))
    p = jax.nn.softmax(jnp.concatenate([s_sink, s], axis=-1), axis=-1)[..., 1:]
    o = jnp.einsum('bhgqk,bkhd->bqhgd', p.astype(vc.dtype), vc)
    return o.reshape(B, L, SWA_HEADS, SWA_DH)


def token_mixers(h, hc, w_in, w_out, lam, lam_init, diff_norm, sink, swa_norm, cos, sin, with_ctx_out):
    dq, dk, dv, sq, sk, sv = split_heads(h @ w_in)
    dqc, dkc, dvc, sqc, skc, svc = split_heads(hc @ w_in)
    dq, dk = apply_rope(dq, cos, sin), apply_rope(dk, cos, sin)
    sq, sk = apply_rope(sq, cos, sin), apply_rope(sk, cos, sin)

    def merge(o_diff, o_swa):
        return jnp.concatenate([head_rms(o_diff, diff_norm) * (1.0 - lam_init),
                                head_rms(o_swa, swa_norm)], axis=-1) @ w_out

    out = merge(diff_latent(dq, dk, dv, dkc, dvc, lam), swa_latent(sq, sk, sv, skc, svc, sink))
    out_c = None
    if with_ctx_out:
        out_c = merge(diff_attend(dqc, dkc, dvc, lam), swa_context(sqc, skc, svc, sink))
    return out, out_c


def peer(h, w_q, sub_keys, u, v):
    B, T, D = h.shape
    q = (h @ w_q).reshape(B, T, PEER_HEADS, 2, PEER_DHALF)
    s = jnp.einsum('bshid,hikd->bshik', q, sub_keys).astype(jnp.float32)
    s1, i1 = lax.top_k(s[..., 0, :], PEER_TOPK)
    s2, i2 = lax.top_k(s[..., 1, :], PEER_TOPK)
    cand = (s1[..., :, None] + s2[..., None, :]).reshape(B, T, PEER_HEADS, PEER_TOPK * PEER_TOPK)
    cidx = (i1[..., :, None] * N_KEYS + i2[..., None, :]).reshape(B, T, PEER_HEADS, PEER_TOPK * PEER_TOPK)
    top_s, pos = lax.top_k(cand, PEER_TOPK)
    idx = jnp.take_along_axis(cidx, pos, axis=-1)
    g = jax.nn.softmax(top_s, axis=-1)
    n_chunks = (B * T) // TOKEN_CHUNK
    hf = h.reshape(n_chunks, TOKEN_CHUNK, D)
    idx = idx.reshape(n_chunks, TOKEN_CHUNK, PEER_HEADS * PEER_TOPK)
    g = g.reshape(n_chunks, TOKEN_CHUNK, PEER_HEADS * PEER_TOPK)

    def one_chunk(args):
        hc, ic, gc = args
        u_sel = u[ic]
        act = jax.nn.gelu(jnp.einsum('cd,ced->ce', hc, u_sel))
        wts = (gc * act.astype(jnp.float32)).astype(v.dtype)
        return jnp.einsum('ce,ced->cd', wts, v[ic])

    return lax.map(one_chunk, (hf, idx, g)).reshape(B, T, D)


def setup_inputs(seed: int = 0) -> dict:
    key = jax.random.key(seed)
    ks = jax.random.split(key, 22)

    def nrm(k, shape, s):
        return jax.random.normal(k, shape, jnp.float32) * s

    D = D_MODEL
    return {
        'x': nrm(ks[0], (BATCH, SEQ, D), 1.0),
        'c': nrm(ks[1], (BATCH, D), 1.0),
        'ctx': nrm(ks[2], (BATCH, CTX_LEN, D), 1.0),
        'c_ctx': nrm(ks[3], (D,), 1.0),
        'w_ada': nrm(ks[4], (DEPTH, D, 6 * D), D ** -0.5),
        'b_ada': nrm(ks[5], (DEPTH, 6 * D), 0.02),
        'norm_attn': 1.0 + nrm(ks[6], (DEPTH, D), 0.02),
        'w_in': nrm(ks[7], (DEPTH, D, PROJ_WIDTH), D ** -0.5),
        'diff_lambda_q1': nrm(ks[8], (DEPTH, DIFF_DH), 0.1),
        'diff_lambda_k1': nrm(ks[9], (DEPTH, DIFF_DH), 0.1),
        'diff_lambda_q2': nrm(ks[10], (DEPTH, DIFF_DH), 0.1),
        'diff_lambda_k2': nrm(ks[11], (DEPTH, DIFF_DH), 0.1),
        'diff_norm': 1.0 + nrm(ks[12], (DEPTH, DIFF_WIDTH), 0.02),
        'swa_sink': nrm(ks[13], (DEPTH, SWA_HEADS), 1.0),
        'swa_norm': 1.0 + nrm(ks[14], (DEPTH, SWA_WIDTH), 0.02),
        'w_out': nrm(ks[15], (DEPTH, MIX_WIDTH, D), MIX_WIDTH ** -0.5),
        'norm_ffn': 1.0 + nrm(ks[16], (DEPTH, D), 0.02),
        'peer_w_q': nrm(ks[17], (DEPTH, D, PEER_HEADS * PEER_DQ), D ** -0.5),
        'peer_sub_keys': nrm(ks[18], (DEPTH, PEER_HEADS, 2, N_KEYS, PEER_DHALF), PEER_DHALF ** -0.5),
        'peer_u': nrm(ks[19], (DEPTH, N_EXPERTS, D), D ** -0.5),
        'peer_v': nrm(ks[20], (DEPTH, N_EXPERTS, D), 1.0),
        'final_norm': 1.0 + nrm(ks[21], (D,), 0.02),
    }


def reference(x, c, ctx, c_ctx, w_ada, b_ada, norm_attn, w_in, diff_lambda_q1, diff_lambda_k1,
              diff_lambda_q2, diff_lambda_k2, diff_norm, swa_sink, swa_norm, w_out, norm_ffn,
              peer_w_q, peer_sub_keys, peer_u, peer_v, final_norm):
    B, S, D = x.shape
    ROWS = S // GRID_W
    cos, sin = axial_rope_tables(ROWS, x.dtype)
    xc = ctx
    for l in range(DEPTH):
        last = l == DEPTH - 1
        mod = jax.nn.silu(c) @ w_ada[l] + b_ada[l]
        mod_c = jax.nn.silu(c_ctx) @ w_ada[l] + b_ada[l]
        sh1, sc1, g1, sh2, sc2, g2 = [m[:, None, :] for m in jnp.split(mod, 6, axis=-1)]
        sh1c, sc1c, g1c, sh2c, sc2c, g2c = jnp.split(mod_c, 6, axis=-1)

        lam_init = 0.8 - 0.6 * math.exp(-0.3 * l)
        lam = (jnp.exp(jnp.sum(diff_lambda_q1[l].astype(jnp.float32) * diff_lambda_k1[l].astype(jnp.float32)))
               - jnp.exp(jnp.sum(diff_lambda_q2[l].astype(jnp.float32) * diff_lambda_k2[l].astype(jnp.float32)))
               + lam_init)

        h = modulate(rms_norm(x, norm_attn[l]), sh1, sc1)
        hc = modulate(rms_norm(xc, norm_attn[l]), sh1c, sc1c)
        a, a_c = token_mixers(h, hc, w_in[l], w_out[l], lam, lam_init, diff_norm[l], swa_sink[l],
                              swa_norm[l], cos, sin, not last)
        x = x + g1 * a
        h2 = modulate(rms_norm(x, norm_ffn[l]), sh2, sc2)
        x = x + g2 * peer(h2, peer_w_q[l], peer_sub_keys[l], peer_u[l], peer_v[l])
        if not last:
            xc = xc + g1c * a_c
            h2c = modulate(rms_norm(xc, norm_ffn[l]), sh2c, sc2c)
            xc = xc + g2c * peer(h2c, peer_w_q[l], peer_sub_keys[l], peer_u[l], peer_v[l])
    return rms_norm(x, final_norm)
```

```cpp
#include <hip/hip_runtime.h>
#include <hip/hip_cooperative_groups.h>
#include <stdint.h>
#include <cstdio>

typedef unsigned short bf16;
constexpr int D = 2048, NB = 4, S = 4096, CL = 256, M = NB * S, MC = NB * CL, MT = M + MC;
constexpr int PW = 4608, MODW = 6 * D;
constexpr float EPS = 1e-6f;

__device__ __forceinline__ float bf2f(bf16 v) { return __uint_as_float(((unsigned)v) << 16); }
__device__ __forceinline__ bf16 f2bf(float f) { unsigned u = __float_as_uint(f); return (bf16)((u + 0x7fffu + ((u >> 16) & 1u)) >> 16); }
__device__ __forceinline__ float wave_sum(float v) {
#pragma unroll
    for (int o = 1; o < 64; o <<= 1) v += __shfl_xor(v, o);
    return v;
}
__device__ __forceinline__ float wave_max(float v) {
#pragma unroll
    for (int o = 1; o < 64; o <<= 1) v = fmaxf(v, __shfl_xor(v, o));
    return v;
}

constexpr size_t MiB = 1u << 20;
constexpr size_t WS_CTL = 0;
constexpr size_t WS_MOD = 1 * MiB;
constexpr size_t WS_MODF = 512 * 1024;
constexpr size_t WS_ROPE = WS_MOD + 512 * 1024;
constexpr size_t WS_AMSH = WS_ROPE + 64 * 1024;
constexpr size_t WS_QBIAS = WS_ROPE + 128 * 1024;
constexpr size_t WS_ROWSS = 256 * 1024;
constexpr size_t WS_SK = 2 * MiB;
constexpr size_t WS_WIN = 3 * MiB;
constexpr size_t WS_WOUT = 21 * MiB;
constexpr size_t WS_WQ = 29 * MiB;
constexpr size_t WS_U = 37 * MiB;
constexpr size_t WS_V = 101 * MiB;
constexpr size_t WS_H = 165 * MiB;
constexpr size_t WS_P = 233 * MiB;
constexpr size_t WS_X1 = WS_P;
constexpr size_t WS_QP = 386 * MiB;
constexpr size_t WS_IDX = 450 * MiB;
constexpr size_t WS_G = 458 * MiB;
constexpr size_t WS_AO = WS_QP;
constexpr size_t WS_WQB = 466 * MiB;
constexpr size_t WS_V8 = 498 * MiB;
constexpr size_t WS_Q8 = 516 * MiB;
constexpr size_t WS_K8 = 534 * MiB;
constexpr size_t WS_SQ8 = WS_P + 64 * MiB;
constexpr size_t WS_SK8 = WS_P + 80 * MiB;
constexpr size_t WS_SV8 = WS_P + 88 * MiB;
constexpr size_t WS_END = 552 * MiB;


namespace pg8 {
#define PG8_LAS __attribute__((address_space(3)))
typedef unsigned short bf16_t;
typedef short bf16x8 __attribute__((ext_vector_type(8)));
typedef float f32x4 __attribute__((ext_vector_type(4)));
typedef unsigned u32x4 __attribute__((ext_vector_type(4)));
constexpr int BM = 256, BK = 64, HALF = 128, HTB = HALF * BK * 2  , STAGE_BYTES = 8 * HTB, NXCD = 8, WGM = 8;

__host__ __device__ __forceinline__ int lds_byte(int r, int c) { const int st = (r >> 4) * 2 + (c >> 5), rr = r & 15, cc = c & 31, ob = rr * 64 + cc * 2; return st * 1024 + (ob ^ (((ob >> 9) & 1) << 5)); }
__host__ __device__ __forceinline__ void stage_rc(int b, int& R, int& C) { const int st = b / 1024, sb = b % 1024, swz = sb ^ (((sb >> 9) & 1) << 5); R = (st >> 1) * 16 + swz / 64; C = (st & 1) * 32 + (swz % 64) / 2; }
__host__ __device__ __forceinline__ int perm32(int rho) { const int n = rho >> 4, i = rho & 15; return 8 * (i >> 2) + 4 * n + (i & 3); }

struct Unit { int pm, pn; };
struct Gemm { const bf16_t* A; const bf16_t* Bt; int M, N, K; };

struct StaticOrder {
    int nM, nN, nwg, G, c;
    __host__ __device__ void init(int M, int N, int G_, int c_) { nM = M / BM; nN = N / BM; nwg = nM * nN; G = G_; c = c_; }
    __host__ __device__ bool next(int i, Unit& u) const {
        const long L = (long)i * G + c; if (L >= nwg) return false;
        int wgid = (int)L; { const int q = nwg / NXCD, r = nwg % NXCD, xcd = wgid % NXCD, off = wgid / NXCD; wgid = (xcd < r ? xcd * (q + 1) : r * (q + 1) + (xcd - r) * q) + off; }
        const int nig = WGM * nN, gid = wgid / nig, fm = gid * WGM, gsz = (nM - fm) < WGM ? (nM - fm) : WGM;
        u.pm = fm + ((wgid % nig) % gsz); u.pn = (wgid % nig) / gsz; return true;
    }
    __device__ __forceinline__ void a_ready(const Unit&) const {}
    __device__ __forceinline__ void done(const Unit&) const {}
};
__device__ __forceinline__ unsigned cvt_pk_bf16(float lo, float hi) { unsigned r; asm volatile("v_cvt_pk_bf16_f32 %0, %1, %2" : "=v"(r) : "v"(lo), "v"(hi)); return r; }

template <class Epi, class Sched, bool ALIGN_EPI = false, bool SP2 = false, bool FP8 = false, int SCA = 127, int SCB = 127>
__device__ __forceinline__ void gemm_phase(PG8_LAS unsigned char* lds, const Gemm g, const Sched& S, const Epi& E) {
    const int tid = threadIdx.x, wid = __builtin_amdgcn_readfirstlane(tid >> 6), lane = tid & 63, wr = wid >> 2, wc = wid & 3, fr = lane & 15, fq = lane >> 4;
    const int K = g.K, nt = K / BK;
    unsigned voffA[2], voffB[2];
#pragma unroll
    for (int i = 0; i < 2; ++i) { int R, C; stage_rc(tid * 16 + i * 8192, R, C); const int Rb = Epi::PERM ? ((R & ~31) + perm32(R & 31)) : R;
        voffA[i] = (unsigned)(R * K + C) * 2u; voffB[i] = (unsigned)(Rb * K + C) * 2u; }
    const size_t kstep = (size_t)(BK * 2);
    const size_t hstep = (size_t)HALF * K * 2;
    const size_t tstep = 2 * hstep;
    const unsigned ldsw = (unsigned)wid * 1024u;
    const int aoff = lds_byte(wr * 64 + fr, fq * 8), boff = lds_byte(wc * 32 + fr, fq * 8);
    const int c81 = fq * 16 + (fq & 1) * 8, c82 = fq * 16 + ((fq & 1) ? 0 : 8);
    const int aoff1 = lds_byte(wr * 64 + fr, c81), aoff2 = lds_byte(wr * 64 + fr, c82), boff1 = lds_byte(wc * 32 + fr, c81), boff2 = lds_byte(wc * 32 + fr, c82);
#define PG8_SA(b, h) (((b) * 2 + (h)) * HTB)
#define PG8_SB(b, h) ((4 + (b) * 2 + (h)) * HTB)
#define PG8_STAGE(bufoff, gbase, voff) do { _Pragma("unroll") for (int _i = 0; _i < 2; ++_i) \
        __builtin_amdgcn_global_load_lds((const unsigned*)((const char*)(gbase) + (voff)[_i]), (PG8_LAS unsigned*)(lds + (bufoff) + ldsw + _i * 8192), 16, 0, 0); } while (0)
#define PG8_LDA(dst, b, h) do { if constexpr (FP8) { _Pragma("unroll") for (int m = 0; m < 4; ++m) { dst##L[m] = *(const PG8_LAS u32x4*)(lds + PG8_SA(b, h) + aoff1 + m * 2048); dst##H[m] = *(const PG8_LAS u32x4*)(lds + PG8_SA(b, h) + aoff2 + m * 2048); } } \
        else { _Pragma("unroll") for (int m = 0; m < 4; ++m) _Pragma("unroll") for (int k = 0; k < 2; ++k) dst[m][k] = *(const PG8_LAS bf16x8*)(lds + PG8_SA(b, h) + aoff + m * 2048 + k * 1024); } } while (0)
#define PG8_LDB(dst, b, h) do { if constexpr (FP8) { _Pragma("unroll") for (int n = 0; n < 2; ++n) { dst##L[n] = *(const PG8_LAS u32x4*)(lds + PG8_SB(b, h) + boff1 + n * 2048); dst##H[n] = *(const PG8_LAS u32x4*)(lds + PG8_SB(b, h) + boff2 + n * 2048); } } \
        else { _Pragma("unroll") for (int n = 0; n < 2; ++n) _Pragma("unroll") for (int k = 0; k < 2; ++k) dst[n][k] = *(const PG8_LAS bf16x8*)(lds + PG8_SB(b, h) + boff + n * 2048 + k * 1024); } } while (0)
#define PG8_CAT8(lo_, hi_) __builtin_bit_cast(i32x8, __builtin_shufflevector(lo_, hi_, 0, 1, 2, 3, 4, 5, 6, 7))
#define PG8_MMA(ai, bj, At, Bt) do { __builtin_amdgcn_s_setprio(1); if constexpr (FP8) { _Pragma("unroll") for (int m = 0; m < 4; ++m) _Pragma("unroll") for (int n = 0; n < 2; ++n) \
            asm volatile("v_mfma_scale_f32_16x16x128_f8f6f4 %0, %1, %2, %0, %3, %4 op_sel_hi:[0,0,0]" : "+v"(acc[ai][bj][m][n]) : "v"(PG8_CAT8(Bt##L[n], Bt##H[n])), "v"(PG8_CAT8(At##L[m], At##H[m])), "v"(scb_), "v"(sca_)); } \
        else { _Pragma("unroll") for (int m = 0; m < 4; ++m) _Pragma("unroll") for (int n = 0; n < 2; ++n) _Pragma("unroll") for (int k = 0; k < 2; ++k) \
            acc[ai][bj][m][n] = __builtin_amdgcn_mfma_f32_16x16x32_bf16(Bt[n][k], At[m][k], acc[ai][bj][m][n], 0, 0, 0); } __builtin_amdgcn_s_setprio(0); } while (0)
#define PG8_WAIT_V(n) asm volatile("s_waitcnt vmcnt(" #n ")" ::: "memory")
#define PG8_WAIT_L(n) asm volatile("s_waitcnt lgkmcnt(" #n ")" ::: "memory")
#define PG8_BAR __builtin_amdgcn_s_barrier()
#define PG8_SCHED __builtin_amdgcn_sched_barrier(0)
    Unit cur, nxt; int ui = 0;
    if (!S.next(0, cur)) return;
    f32x4 acc[2][2][4][2];
#pragma unroll
    for (int a = 0; a < 2; ++a)
#pragma unroll
        for (int b = 0; b < 2; ++b)
#pragma unroll
            for (int m = 0; m < 4; ++m)
#pragma unroll
                for (int n = 0; n < 2; ++n) acc[a][b][m][n] = (f32x4){0.f, 0.f, 0.f, 0.f};
    bf16x8 At[4][2], B0[2][2], B1[2][2];
    typedef int i32x8 __attribute__((ext_vector_type(8)));
    u32x4 AtL[4], AtH[4], B0L[2], B0H[2], B1L[2], B1H[2];
    const int scb_ = SCB * 0x01010101, sca_ = SCA * 0x01010101;
    const char* cA = (const char*)g.A + (size_t)cur.pm * tstep; const char* cB = (const char*)g.Bt + (size_t)cur.pn * tstep;
    S.a_ready(cur);
    if constexpr (SP2) {
        PG8_STAGE(PG8_SB(0, 0), cB, voffB); PG8_STAGE(PG8_SB(0, 1), cB + hstep, voffB); PG8_STAGE(PG8_SA(0, 0), cA, voffA); PG8_STAGE(PG8_SA(0, 1), cA + hstep, voffA);
        if (wr == 1) PG8_BAR;
        PG8_WAIT_V(2); PG8_BAR;
        PG8_STAGE(PG8_SB(1, 0), cB + kstep, voffB); PG8_STAGE(PG8_SA(1, 0), cA + kstep, voffA); PG8_STAGE(PG8_SB(1, 1), cB + hstep + kstep, voffB);
        PG8_WAIT_V(6); PG8_BAR;
    } else {
        PG8_STAGE(PG8_SB(0, 0), cB, voffB); PG8_STAGE(PG8_SA(0, 0), cA, voffA); PG8_STAGE(PG8_SB(0, 1), cB + hstep, voffB); PG8_STAGE(PG8_SA(0, 1), cA + hstep, voffA);
        if (wr == 1) PG8_BAR;
        PG8_WAIT_V(4); PG8_BAR;
        PG8_STAGE(PG8_SB(1, 0), cB + kstep, voffB); PG8_STAGE(PG8_SA(1, 0), cA + kstep, voffA); PG8_STAGE(PG8_SB(1, 1), cB + hstep + kstep, voffB);
        PG8_WAIT_V(6); PG8_BAR;
    }
    for (;;) {
        const bool has_next = S.next(ui + 1, nxt);
        const char* nA = has_next ? (const char*)g.A + (size_t)nxt.pm * tstep : cA; const char* nB = has_next ? (const char*)g.Bt + (size_t)nxt.pn * tstep : cB;
        for (int t = 0; t < nt; t += 2) {
            const bool last = (t == nt - 2);
            const char* a1 = cA + (size_t)(t + 1) * kstep;
            const char* a2 = last ? nA : cA + (size_t)(t + 2) * kstep; const char* b2 = last ? nB : cB + (size_t)(t + 2) * kstep;
            const char* a3 = a2 + kstep; const char* b3 = b2 + kstep;
            if (last && has_next) S.a_ready(nxt);
            if constexpr (SP2) {
            PG8_LDB(B0, 0, 0); PG8_LDB(B1, 0, 1); PG8_SCHED; PG8_LDA(At, 0, 0); PG8_STAGE(PG8_SA(1, 1), a1 + hstep, voffA);
            PG8_WAIT_V(8); PG8_WAIT_L(0); PG8_BAR; PG8_MMA(0, 0, At, B0); PG8_MMA(0, 1, At, B1); PG8_BAR; PG8_SCHED;
            PG8_LDA(At, 0, 1); PG8_STAGE(PG8_SB(0, 0), b2, voffB); PG8_STAGE(PG8_SB(0, 1), b2 + hstep, voffB); PG8_STAGE(PG8_SA(0, 0), a2, voffA);
            PG8_WAIT_V(8); PG8_WAIT_L(0); PG8_BAR; PG8_MMA(1, 0, At, B0); PG8_MMA(1, 1, At, B1); PG8_BAR; PG8_SCHED;
            PG8_LDB(B0, 1, 0); PG8_LDB(B1, 1, 1); PG8_SCHED; PG8_LDA(At, 1, 0); PG8_STAGE(PG8_SA(0, 1), a2 + hstep, voffA);
            PG8_WAIT_V(8); PG8_WAIT_L(0); PG8_BAR; PG8_MMA(0, 0, At, B0); PG8_MMA(0, 1, At, B1); PG8_BAR; PG8_SCHED;
            PG8_LDA(At, 1, 1); PG8_STAGE(PG8_SB(1, 0), b3, voffB); PG8_STAGE(PG8_SB(1, 1), b3 + hstep, voffB); PG8_STAGE(PG8_SA(1, 0), a3, voffA);
            PG8_WAIT_V(8); PG8_WAIT_L(0); PG8_BAR; PG8_MMA(1, 0, At, B0); PG8_MMA(1, 1, At, B1); PG8_BAR; PG8_SCHED;
            } else {
            PG8_LDB(B0, 0, 0); PG8_SCHED; PG8_LDA(At, 0, 0); PG8_STAGE(PG8_SA(1, 1), a1 + hstep, voffA);
            PG8_WAIT_L(8); PG8_BAR; PG8_WAIT_L(0); PG8_MMA(0, 0, At, B0); PG8_BAR; PG8_SCHED;
            PG8_LDB(B1, 0, 1); PG8_STAGE(PG8_SB(0, 0), b2, voffB);
            PG8_BAR; PG8_WAIT_L(0); PG8_MMA(0, 1, At, B1); PG8_BAR;
            PG8_LDA(At, 0, 1); PG8_STAGE(PG8_SA(0, 0), a2, voffA);
            PG8_BAR; PG8_WAIT_L(0); PG8_MMA(1, 0, At, B0); PG8_BAR; PG8_SCHED;
            PG8_STAGE(PG8_SB(0, 1), b2 + hstep, voffB);
            PG8_WAIT_V(6); PG8_BAR; PG8_MMA(1, 1, At, B1); PG8_BAR;
            PG8_LDB(B0, 1, 0); PG8_SCHED; PG8_LDA(At, 1, 0); PG8_STAGE(PG8_SA(0, 1), a2 + hstep, voffA);
            PG8_WAIT_L(8); PG8_BAR; PG8_WAIT_L(0); PG8_MMA(0, 0, At, B0); PG8_BAR; PG8_SCHED;
            PG8_LDB(B1, 1, 1); PG8_STAGE(PG8_SB(1, 0), b3, voffB);
            PG8_BAR; PG8_WAIT_L(0); PG8_MMA(0, 1, At, B1); PG8_BAR;
            PG8_LDA(At, 1, 1); PG8_STAGE(PG8_SA(1, 0), a3, voffA);
            PG8_BAR; PG8_WAIT_L(0); PG8_MMA(1, 0, At, B0); PG8_BAR; PG8_SCHED;
            PG8_STAGE(PG8_SB(1, 1), b3 + hstep, voffB);
            PG8_WAIT_V(6); PG8_BAR; PG8_MMA(1, 1, At, B1); PG8_BAR;
            }
        }
        if constexpr (ALIGN_EPI) { if (wr == 0) PG8_BAR; }
        if constexpr (FP8) asm volatile("s_nop 15\n\ts_nop 7" ::: "memory");
        if constexpr (!Epi::AFTER_DRAIN) { E(acc, cur, wr, wc, fr, fq); S.done(cur); }
        if (!has_next) break;
#pragma unroll
        for (int a = 0; a < 2; ++a)
#pragma unroll
            for (int b = 0; b < 2; ++b)
#pragma unroll
                for (int m = 0; m < 4; ++m)
#pragma unroll
                    for (int n = 0; n < 2; ++n) acc[a][b][m][n] = (f32x4){0.f, 0.f, 0.f, 0.f};
        cur = nxt; cA = nA; cB = nB; ++ui;
        if constexpr (ALIGN_EPI) { if (wr == 1) PG8_BAR; }
    }
    PG8_WAIT_V(0);
    if constexpr (!ALIGN_EPI) { if (wr == 0) PG8_BAR; }
    PG8_BAR;
    if constexpr (Epi::AFTER_DRAIN) { E.fused(acc, cur, wr, wc, fr, fq, lds, wid, lane); S.done(cur); }
#undef PG8_SA
#undef PG8_SB
#undef PG8_STAGE
#undef PG8_LDA
#undef PG8_LDB
#undef PG8_MMA
#undef PG8_WAIT_V
#undef PG8_WAIT_L
#undef PG8_BAR
#undef PG8_SCHED
}
}

#define LAS __attribute__((address_space(3)))
typedef float f32x4 __attribute__((ext_vector_type(4)));
typedef unsigned u32x4 __attribute__((ext_vector_type(4)));
typedef unsigned u32x2 __attribute__((ext_vector_type(2)));
typedef float v16f __attribute__((ext_vector_type(16)));
typedef float v32f __attribute__((ext_vector_type(32)));
typedef unsigned v6u __attribute__((ext_vector_type(6)));
constexpr int NWAVES = 8, NTHREADS = 512;
constexpr int RING_BYTES = 131072, LDS_BYTES = 163840;

__device__ __forceinline__ unsigned pk2(float lo, float hi) { return (unsigned)f2bf(lo) | ((unsigned)f2bf(hi) << 16); }
__device__ __forceinline__ float xchg32(float v) { const unsigned x = __float_as_uint(v); auto r = __builtin_amdgcn_permlane32_swap(x, x, false, false); return __uint_as_float(r[0] ^ r[1] ^ x); }


__device__ __forceinline__ f32x4 modf4(const long long* __restrict__ p) {
    const u32x4 a = *(const u32x4*)p, b = *(const u32x4*)(p + 2);
    f32x4 r;
    r[0] = (float)(int)a.y + (float)a.x * 2.3283064365386963e-10f; r[1] = (float)(int)a.w + (float)a.z * 2.3283064365386963e-10f;
    r[2] = (float)(int)b.y + (float)b.x * 2.3283064365386963e-10f; r[3] = (float)(int)b.w + (float)b.z * 2.3283064365386963e-10f;
    return r;
}
struct Order1 {
    int G, c;
    __device__ __forceinline__ bool next(int i, pg8::Unit& u) const {
        const int L = i * G + c;
        if (L < 1152) { const int xcd = L & 7, off = L >> 3; u.pm = 8 * xcd + (off & 7); u.pn = off >> 3; return true; }
        if (L < 1192) { const int r = L - 1152; u.pm = 64 + (r & 3); const int j = r >> 2; u.pn = j < 8 ? 4 + j : 8 + j; return true; }
        return false;
    }
    __device__ __forceinline__ void a_ready(const pg8::Unit&) const {}
    __device__ __forceinline__ void done(const pg8::Unit&) const {}
};
struct EpiRope {
    static constexpr bool PERM = true, AFTER_DRAIN = false;
    bf16* O; const float* tab; unsigned char* V8;
    __device__ __forceinline__ void operator()(const pg8::f32x4 (&acc)[2][2][4][2], const pg8::Unit& u, int wr, int wc, int fr, int fq) const {
        const int row0 = u.pm * 256 + wr * 64 + fr, col0 = u.pn * 256 + wc * 32 + 8 * fq;
        const size_t off8 = u.pn < 4 ? WS_Q8 : (u.pn < 8 ? WS_K8 : (u.pn < 12 ? WS_V8 : (u.pn < 16 ? WS_SQ8 : (u.pn == 16 ? WS_SK8 : WS_SV8))));
        const int rs8 = u.pn < 16 ? 1024 : 256, c8 = u.pn < 4 ? 0 : (u.pn < 8 ? 1024 : (u.pn < 12 ? 2048 : (u.pn < 16 ? 3072 : (u.pn == 16 ? 4096 : 4352))));
        unsigned char* const d8 = V8 + off8;
        const bool rope = (u.pm < 64) && (u.pn < 8 || (u.pn >= 12 && u.pn <= 16));
        const bool lo_half = fq < 2;
        const float qsc = (u.pm < 64 && (u.pn < 4 || (u.pn >= 12 && u.pn < 16))) ? 1.4426950408889634f : 1.f;
        const int pbase = 8 * (fq & 1);
#pragma unroll
        for (int ai = 0; ai < 2; ++ai)
#pragma unroll
            for (int m = 0; m < 4; ++m) {
                const int row = row0 + ai * 128 + m * 16;
                f32x4 c0 = {1.f, 1.f, 1.f, 1.f}, c1 = c0, s0 = {0.f, 0.f, 0.f, 0.f}, s1 = s0;
                if (rope) { const int s = row & 4095; const int pos = (wc & 1) ? (s & 63) : (s >> 6); const float* tp = tab + pos * 16 + pbase;
                    c0 = *(const f32x4*)tp; c1 = *(const f32x4*)(tp + 4); s0 = *(const f32x4*)(tp + 1024); s1 = *(const f32x4*)(tp + 1028);
                    if (lo_half) { s0 = -s0; s1 = -s1; } }
                bf16* rowp = O + (size_t)row * PW + col0;
#pragma unroll
                for (int bj = 0; bj < 2; ++bj) {
                    f32x4 v0 = acc[ai][bj][m][0], v1 = acc[ai][bj][m][1];
                    if (rope) {
#pragma unroll
                        for (int j = 0; j < 4; ++j) { const float w0 = xchg32(v0[j]), w1 = xchg32(v1[j]); v0[j] = v0[j] * c0[j] + w0 * s0[j]; v1[j] = v1[j] * c1[j] + w1 * s1[j]; }
                    }
                    v0 = v0 * qsc; v1 = v1 * qsc;
                    int a8 = 0, b8 = 0;
                    a8 = __builtin_amdgcn_cvt_pk_fp8_f32(v0[0], v0[1], a8, false); a8 = __builtin_amdgcn_cvt_pk_fp8_f32(v0[2], v0[3], a8, true);
                    b8 = __builtin_amdgcn_cvt_pk_fp8_f32(v1[0], v1[1], b8, false); b8 = __builtin_amdgcn_cvt_pk_fp8_f32(v1[2], v1[3], b8, true);
                    *(u32x2*)(d8 + (size_t)row * rs8 + (col0 - c8) + bj * 128) = (u32x2){(unsigned)a8, (unsigned)b8};
                }
            }
    }
};
struct EpiRes {
    static constexpr bool PERM = true, AFTER_DRAIN = false;
    const float* x; const long long* mod; bf16* x1; unsigned long long* rowss;
    __device__ __forceinline__ void operator()(const pg8::f32x4 (&acc)[2][2][4][2], const pg8::Unit& u, int wr, int wc, int fr, int fq) const {
        const int row0 = u.pm * 256 + wr * 64 + fr, col0 = u.pn * 256 + wc * 32 + 8 * fq; const int b = u.pm >> 4;
        f32x4 g[2][2];
#pragma unroll
        for (int bj = 0; bj < 2; ++bj)
#pragma unroll
            for (int n = 0; n < 2; ++n) g[bj][n] = modf4(mod + (size_t)b * MODW + 2 * D + col0 + bj * 128 + n * 4);
#pragma unroll
        for (int ai = 0; ai < 2; ++ai)
#pragma unroll
            for (int mp = 0; mp < 2; ++mp) {
                f32x4 xs[2][2][2];
#pragma unroll
                for (int mm = 0; mm < 2; ++mm) { const size_t off = (size_t)(row0 + ai * 128 + (mp * 2 + mm) * 16) * D + col0;
#pragma unroll
                    for (int bj = 0; bj < 2; ++bj)
#pragma unroll
                        for (int n = 0; n < 2; ++n) xs[mm][bj][n] = *(const f32x4*)(x + off + bj * 128 + n * 4); }
#pragma unroll
                for (int mm = 0; mm < 2; ++mm) { const size_t off = (size_t)(row0 + ai * 128 + (mp * 2 + mm) * 16) * D + col0;
                    float ssr = 0.f;
#pragma unroll
                    for (int bj = 0; bj < 2; ++bj) { const f32x4 v0 = xs[mm][bj][0] + g[bj][0] * acc[ai][bj][mp * 2 + mm][0], v1 = xs[mm][bj][1] + g[bj][1] * acc[ai][bj][mp * 2 + mm][1];
                        u32x4 w; w.x = pk2(v0[0], v0[1]); w.y = pk2(v0[2], v0[3]); w.z = pk2(v1[0], v1[1]); w.w = pk2(v1[2], v1[3]);
                        ssr += ((v0[0] * v0[0] + v0[1] * v0[1]) + (v0[2] * v0[2] + v0[3] * v0[3])) + ((v1[0] * v1[0] + v1[1] * v1[1]) + (v1[2] * v1[2] + v1[3] * v1[3]));
                        *(u32x4*)(x1 + off + bj * 128) = w; }
                    ssr += __shfl_xor(ssr, 16); ssr += __shfl_xor(ssr, 32);
                    if (fq == 0) atomicAdd(rowss + (row0 + ai * 128 + (mp * 2 + mm) * 16), (unsigned long long)__float2ll_rn(ssr * 4294967296.f)); }
                asm volatile("" ::: "memory"); }
    }
};
struct EpiQ2 {
    static constexpr bool PERM = true, AFTER_DRAIN = false;
    bf16* O; const unsigned long long* rowss; const float* qbias;
    __device__ __forceinline__ void operator()(const pg8::f32x4 (&acc)[2][2][4][2], const pg8::Unit& u, int wr, int wc, int fr, int fq) const {
        const int row0 = u.pm * 256 + wr * 64 + fr, col0 = (u.pn & 7) * 256 + wc * 32 + 8 * fq; const int b = u.pm >> 4;
        f32x4 bs[2][2];
#pragma unroll
        for (int bj = 0; bj < 2; ++bj)
#pragma unroll
            for (int n = 0; n < 2; ++n) bs[bj][n] = *(const f32x4*)(qbias + (size_t)b * D + col0 + bj * 128 + n * 4);
#pragma unroll
        for (int ai = 0; ai < 2; ++ai)
#pragma unroll
            for (int m = 0; m < 4; ++m) { const int row = row0 + ai * 128 + m * 16;
                const unsigned long long sv = rowss[row];
                const float ss = (float)(int)(unsigned)(sv >> 32) + (float)(unsigned)sv * 2.3283064365386963e-10f;
                const float rstd = rsqrtf(ss * (1.f / D) + EPS);
                bf16* rowp = O + (size_t)row * D + col0;
#pragma unroll
                for (int bj = 0; bj < 2; ++bj) { const f32x4 v0 = acc[ai][bj][m][0] * rstd + bs[bj][0], v1 = acc[ai][bj][m][1] * rstd + bs[bj][1];
                    u32x4 w; w.x = pk2(v0[0], v0[1]); w.y = pk2(v0[2], v0[3]); w.z = pk2(v1[0], v1[1]); w.w = pk2(v1[2], v1[3]);
                    *(u32x4*)(rowp + bj * 128) = w; } }
    }
};
struct Order6 {
    pg8::StaticOrder S;
    __device__ __forceinline__ bool next(int i, pg8::Unit& u) const { if (!S.next(i, u)) return false; u.pn += 8 * (u.pm >> 4); return true; }
    __device__ __forceinline__ void a_ready(const pg8::Unit&) const {}
    __device__ __forceinline__ void done(const pg8::Unit&) const {}
};
struct EpiQ {
    static constexpr bool PERM = true, AFTER_DRAIN = false;
    bf16* O;
    __device__ __forceinline__ void operator()(const pg8::f32x4 (&acc)[2][2][4][2], const pg8::Unit& u, int wr, int wc, int fr, int fq) const {
        asm volatile("s_nop 15\n\ts_nop 7" ::: "memory");
        const int row0 = u.pm * 256 + wr * 64 + fr, col0 = u.pn * 256 + wc * 32 + 8 * fq;
#pragma unroll
        for (int ai = 0; ai < 2; ++ai)
#pragma unroll
            for (int m = 0; m < 4; ++m) { bf16* rowp = O + (size_t)(row0 + ai * 128 + m * 16) * D + col0;
#pragma unroll
                for (int bj = 0; bj < 2; ++bj) { const f32x4 v0 = acc[ai][bj][m][0], v1 = acc[ai][bj][m][1];
                    u32x4 w; w.x = pg8::cvt_pk_bf16(v0[0], v0[1]); w.y = pg8::cvt_pk_bf16(v0[2], v0[3]); w.z = pg8::cvt_pk_bf16(v1[0], v1[1]); w.w = pg8::cvt_pk_bf16(v1[2], v1[3]);
                    *(u32x4*)(rowp + bj * 128) = w; } }
    }
};

struct Args { const float* in[22]; float* out; unsigned char* ws; int ph_lo, ph_hi, tab_r0; };
constexpr int TAB_R0 = 20480;

__device__ __forceinline__ void p0_transpose_item(const float* __restrict__ W, int K, int N, bf16* __restrict__ WT, LAS float* scr, int item, int lane) {
    const int nblk = N / 32, kb = item / nblk, nb = item % nblk, k0 = 64 * kb, n0 = 32 * nb;
    float t_[32];
    const float* wp = W + (size_t)(k0 + (lane >> 5)) * N + n0 + (lane & 31);
#pragma unroll
    for (int i = 0; i < 32; ++i) t_[i] = wp[(size_t)(2 * i) * N];
#pragma unroll
    for (int i = 0; i < 32; ++i) scr[(2 * i + (lane >> 5)) * 33 + (lane & 31)] = t_[i];
    asm volatile("s_waitcnt lgkmcnt(0)" ::: "memory");
    const int c = lane & 7;
#pragma unroll
    for (int j = 0; j < 4; ++j) { const int n = (lane >> 3) + 8 * j; const LAS float* s = scr + (8 * c) * 33 + n;
        u32x4 o; o.x = pk2(s[0 * 33], s[1 * 33]); o.y = pk2(s[2 * 33], s[3 * 33]); o.z = pk2(s[4 * 33], s[5 * 33]); o.w = pk2(s[6 * 33], s[7 * 33]);
        *(u32x4*)(WT + (size_t)(n0 + n) * K + k0 + 8 * c) = o; }
    asm volatile("s_waitcnt lgkmcnt(0)" ::: "memory");
}
__device__ __forceinline__ void p0_transpose_item8(const float* __restrict__ W, int K, int N, unsigned char* __restrict__ WT, LAS float* scr, int item, int lane, float SC) {
    const int nblk = N / 32, kb = item / nblk, nb = item % nblk, k0 = 64 * kb, n0 = 32 * nb;
    float t_[32];
    const float* wp = W + (size_t)(k0 + (lane >> 5)) * N + n0 + (lane & 31);
#pragma unroll
    for (int i = 0; i < 32; ++i) t_[i] = wp[(size_t)(2 * i) * N];
#pragma unroll
    for (int i = 0; i < 32; ++i) scr[(2 * i + (lane >> 5)) * 33 + (lane & 31)] = t_[i] * SC;
    asm volatile("s_waitcnt lgkmcnt(0)" ::: "memory");
    const int c = lane & 7;
#pragma unroll
    for (int j = 0; j < 4; ++j) { const int n = (lane >> 3) + 8 * j; const LAS float* s = scr + (8 * c) * 33 + n;
        int a8 = 0, b8 = 0;
        a8 = __builtin_amdgcn_cvt_pk_fp8_f32(s[0 * 33], s[1 * 33], a8, false); a8 = __builtin_amdgcn_cvt_pk_fp8_f32(s[2 * 33], s[3 * 33], a8, true);
        b8 = __builtin_amdgcn_cvt_pk_fp8_f32(s[4 * 33], s[5 * 33], b8, false); b8 = __builtin_amdgcn_cvt_pk_fp8_f32(s[6 * 33], s[7 * 33], b8, true);
        *(u32x2*)(WT + (size_t)(n0 + n) * K + k0 + 8 * c) = (u32x2){(unsigned)a8, (unsigned)b8}; }
    asm volatile("s_waitcnt lgkmcnt(0)" ::: "memory");
}
__device__ __forceinline__ void p0_enc_row(const Args& a, int r, const f32x4 (&v)[8], int lane) {
    unsigned char* ws = a.ws;
    const bool isv = r >= 16384; const int row = isv ? r - 16384 : r;
    float mx = 0.f;
#pragma unroll
    for (int j = 0; j < 8; ++j) mx = fmaxf(fmaxf(mx, fmaxf(fabsf(v[j][0]), fabsf(v[j][1]))), fmaxf(fabsf(v[j][2]), fabsf(v[j][3])));
    mx = wave_max(mx);
    if (!isv) {
        const float qs = mx > 0.f ? 7.5f / mx : 1.f;
        v16f xa, xb;
#pragma unroll
        for (int j = 0; j < 4; ++j)
#pragma unroll
            for (int k = 0; k < 4; ++k) { const float e0_ = v[j][k] * qs, e1_ = v[4 + j][k] * qs;
                if (((4 * j + k) & 1) == 0) { xa[(4 * j + k) >> 1] = e0_; xa[(16 + 4 * j + k) >> 1] = e1_; } else { xb[(4 * j + k) >> 1] = e0_; xb[(16 + 4 * j + k) >> 1] = e1_; } }
        const v6u p = __builtin_amdgcn_cvt_scalef32_2xpk16_fp6_f32(xa, xb, 1.0f);
        unsigned char* dst = ws + WS_U + (size_t)row * 2048;
        *(u32x4*)(dst + lane * 16) = (u32x4){p[0], p[1], p[2], p[3]}; *(u32x2*)(dst + 1024 + lane * 8) = (u32x2){p[4], p[5]};
        if (lane == 0) ((float*)(ws + WS_U + 32 * MiB))[row] = mx > 0.f ? mx * (1.f / 7.5f) : 1.f;
    } else {
        const float qs = mx > 0.f ? 6.f / mx : 1.f;
        u32x4 p = {0u, 0u, 0u, 0u};
#define P0_FP4_DW(d, ja, jb) do { \
        p[d] = __builtin_amdgcn_cvt_scalef32_pk_fp4_f32(p[d], v[ja][0] * qs, v[ja][1] * qs, 1.0f, 0); p[d] = __builtin_amdgcn_cvt_scalef32_pk_fp4_f32(p[d], v[ja][2] * qs, v[ja][3] * qs, 1.0f, 1); \
        p[d] = __builtin_amdgcn_cvt_scalef32_pk_fp4_f32(p[d], v[jb][0] * qs, v[jb][1] * qs, 1.0f, 2); p[d] = __builtin_amdgcn_cvt_scalef32_pk_fp4_f32(p[d], v[jb][2] * qs, v[jb][3] * qs, 1.0f, 3); } while (0)
        P0_FP4_DW(0, 0, 1); P0_FP4_DW(1, 2, 3); P0_FP4_DW(2, 4, 5); P0_FP4_DW(3, 6, 7);
#undef P0_FP4_DW
        *(u32x4*)(ws + WS_V + (size_t)row * 1024 + lane * 16) = p;
        if (lane == 0) ((float*)(ws + WS_V + 32 * MiB))[row] = mx > 0.f ? mx * (1.f / 6.f) : 1.f;
    }
}
__device__ __forceinline__ const float* p0_tab_src(const Args& a, int r, int lane) { return (r >= 16384 ? a.in[20] + (size_t)(r - 16384) * D : a.in[19] + (size_t)r * D) + lane * 4; }
#define P0_TAB_LOAD(v_, r_, ok_) do { const float* s_ = p0_tab_src(a, (ok_) ? (r_) : r, lane); _Pragma("unroll") for (int j = 0; j < 8; ++j) v_[j] = *(const f32x4*)(s_ + 256 * j); } while (0)
template <int NR>
__device__ __forceinline__ void p0_tables(const Args& a, int r0, int r1, int w, int nw, int lane) {
    for (int r = r0 + w; r < r1; r += NR * nw) {
        const int rb = r + nw, rc = r + 2 * nw, rd = r + 3 * nw;
        const bool hb = NR > 1 && rb < r1, hc = NR > 2 && rc < r1, hd = NR > 2 && rd < r1;
        f32x4 va[8], vb[8], vc[8], vd[8];
        P0_TAB_LOAD(va, r, true);
        if (NR > 1) P0_TAB_LOAD(vb, rb, hb);
        if (NR > 2) { P0_TAB_LOAD(vc, rc, hc); P0_TAB_LOAD(vd, rd, hd); }
        p0_enc_row(a, r, va, lane);
        if (hb) p0_enc_row(a, rb, vb, lane);
        if (hc) p0_enc_row(a, rc, vc, lane);
        if (hd) p0_enc_row(a, rd, vd, lane);
    }
}
__device__ __forceinline__ void p0_prep(const Args& a, LAS unsigned char* lds, int gw, int NGW, int wave, int lane) {
    unsigned char* ws = a.ws;
    unsigned long long* MOD = (unsigned long long*)(ws + WS_MOD);
    {
        const int vcu = gw >> 3, G_ = NGW >> 3, tid = wave * 64 + lane;
        LAS float* part = (LAS float*)lds;
        for (int item = vcu; item < 192; item += G_) {
            const int nc = item % 48, kc = (item / 48) * 8 + wave, k0 = kc * 64, n0 = nc * 256 + lane * 4;
            float sv[5];
#pragma unroll
            for (int r = 0; r < 5; ++r) { const float v = r < 4 ? a.in[1][r * D + k0 + lane] : a.in[3][k0 + lane]; sv[r] = v / (1.f + __expf(-v)); }
            f32x4 acc[5];
#pragma unroll
            for (int r = 0; r < 5; ++r) acc[r] = (f32x4){0.f, 0.f, 0.f, 0.f};
            const float* wp = a.in[4] + (size_t)k0 * MODW + n0;
#pragma unroll 8
            for (int kk = 0; kk < 64; ++kk) { const f32x4 w = *(const f32x4*)(wp + (size_t)kk * MODW);
#pragma unroll
                for (int r = 0; r < 5; ++r) { const float s = __int_as_float(__builtin_amdgcn_readlane(__float_as_int(sv[r]), kk)); acc[r] += w * s; } }
            if (kc == 0) { const f32x4 bb = *(const f32x4*)(a.in[5] + n0);
#pragma unroll
                for (int r = 0; r < 5; ++r) acc[r] += bb; }
#pragma unroll
            for (int r = 0; r < 5; ++r) *(LAS f32x4*)(part + (wave * 5 + r) * 256 + lane * 4) = acc[r];
            __syncthreads();
            for (int o = tid; o < 5 * 256; o += NTHREADS) { const int r = o >> 8, c = o & 255;
                float sum = part[(0 * 5 + r) * 256 + c];
#pragma unroll
                for (int w = 1; w < 8; ++w) sum += part[(w * 5 + r) * 256 + c];
                atomicAdd(MOD + (size_t)r * MODW + nc * 256 + c, (unsigned long long)__float2ll_rn(sum * 4294967296.f)); }
            __syncthreads();
        }
    }
    const int ngv_ = (NGW >> 3) > 192 ? 192 * 8 : NGW;
    const int s0_ = gw < ngv_ ? gw * 3 : ngv_ * 3 + (gw - ngv_) * 7, ns_ = gw < ngv_ ? 3 : 7, NSL_ = ngv_ * 3 + (NGW - ngv_) * 7;
    {
        LAS float* scr = (LAS float*)(lds + wave * 16384);
        constexpr int I_IN = (D / 64) * (PW / 32), I_O = (D / 64) * (D / 32);
        for (int sl = s0_; sl < s0_ + ns_; ++sl)
        for (int it = sl; it < I_IN + 2 * I_O; it += NSL_) {
            int r = it;
            if (r < I_IN) { p0_transpose_item8(a.in[7], D, PW, ws + WS_WIN, scr, r, lane, 32.f); continue; } r -= I_IN;
            if (r < I_O) { p0_transpose_item8(a.in[15], D, D, ws + WS_WOUT, scr, r, lane, 32.f); continue; } r -= I_O;
            p0_transpose_item(a.in[17], D, D, (bf16*)(ws + WS_WQ), scr, r, lane);
        }
    }
    for (int sl = s0_; sl < s0_ + ns_; ++sl) p0_tables<2>(a, 0, a.tab_r0, sl, NSL_, lane);
    for (int sl = s0_; sl < s0_ + ns_; ++sl)
    for (int ch = sl; ch < 16 * 128 * 128 / 512; ch += NSL_) {
        const float* src = a.in[18] + (size_t)ch * 512 + lane * 8; const f32x4 v0 = *(const f32x4*)src, v1 = *(const f32x4*)(src + 4);
        u32x4 o; o.x = pk2(v0[0], v0[1]); o.y = pk2(v0[2], v0[3]); o.z = pk2(v1[0], v1[1]); o.w = pk2(v1[2], v1[3]);
        *(u32x4*)((bf16*)(ws + WS_SK) + (size_t)ch * 512 + lane * 8) = o;
    }
    if (gw == NGW - 1) { float* tab = (float*)(ws + WS_ROPE);
        for (int i = lane; i < 1024; i += 64) { const int pos = i >> 4, p = i & 15; const float f = powf(10000.f, -(float)p / 16.f); const float ang = (float)pos * f; tab[i] = cosf(ang); tab[1024 + i] = sinf(ang); } }
}
__device__ __forceinline__ void p1_fold(const Args& a, LAS unsigned char* lds, int gw, int NGW, int tid, int lane) {
    unsigned char* ws = a.ws;
    const long long* mod = (const long long*)(ws + WS_MOD);
    const bf16* WQT = (const bf16*)(ws + WS_WQ); bf16* WQB = (bf16*)(ws + WS_WQB);
    float* QB = (float*)(ws + WS_QBIAS);
    const float* gain = a.in[16];
    LAS float* Al = (LAS float*)lds; LAS float* Sl = Al + NB * D;
#pragma unroll
    for (int i = 0; i < 4; ++i) { const int idx = (i * NTHREADS + tid) * 4, b = idx >> 11, k = idx & (D - 1);
        const f32x4 am = *(const f32x4*)(gain + k) * (modf4(mod + (size_t)b * MODW + 4 * D + k) + 1.f), sh = modf4(mod + (size_t)b * MODW + 3 * D + k);
        *(LAS f32x4*)(Al + idx) = am; *(LAS f32x4*)(Sl + idx) = sh;
        if (blockIdx.x == 0) { *(f32x4*)((float*)(ws + WS_AMSH) + idx) = am; *(f32x4*)((float*)(ws + WS_AMSH) + NB * D + idx) = sh; } }
    __syncthreads();
    for (int n = gw; n < D; n += NGW) {
        f32x4 w[8];
#pragma unroll
        for (int j = 0; j < 8; ++j) { const u32x2 r = *(const u32x2*)(WQT + (size_t)n * D + lane * 4 + 256 * j);
            w[j] = (f32x4){__uint_as_float(r.x << 16), __uint_as_float(r.x & 0xffff0000u), __uint_as_float(r.y << 16), __uint_as_float(r.y & 0xffff0000u)}; }
#pragma unroll 1
        for (int b = 0; b < NB; ++b) {
            float bsum = 0.f;
#pragma unroll
            for (int j = 0; j < 8; ++j) { const f32x4 am = *(LAS const f32x4*)(Al + b * D + lane * 4 + 256 * j), sh = *(LAS const f32x4*)(Sl + b * D + lane * 4 + 256 * j);
                const f32x4 y = w[j] * am; bsum += (w[j][0] * sh[0] + w[j][1] * sh[1]) + (w[j][2] * sh[2] + w[j][3] * sh[3]);
                u32x2 o; o.x = pk2(y[0], y[1]); o.y = pk2(y[2], y[3]); *(u32x2*)(WQB + ((size_t)b * D + n) * D + lane * 4 + 256 * j) = o; }
            bsum = wave_sum(bsum);
            if (lane == 0) QB[(size_t)b * D + n] = bsum;
        }
    }
}
#define NORM_AB(gain, mrow, scale_off, shift_off) do { _Pragma("unroll") for (int j = 0; j < 8; ++j) { const f32x4 g4 = *(const f32x4*)((gain) + lane * 4 + 256 * j); \
        A_[j] = g4 * (modf4((mrow) + (scale_off) + 256 * j) + 1.f); B_[j] = modf4((mrow) + (shift_off) + 256 * j); } } while (0)
#define NORM_OUT(v_, ss_, o_) do { const float rstd_ = rsqrtf(wave_sum(ss_) * (1.f / D) + EPS); _Pragma("unroll") for (int j = 0; j < 8; ++j) { const f32x4 y = v_[j] * rstd_ * A_[j] + B_[j]; \
        u32x2 w; w.x = pk2(y[0], y[1]); w.y = pk2(y[2], y[3]); *(u32x2*)((o_) + 256 * j) = w; } } while (0)
#define NORM_OUT8(v_, ss_, o_) do { const float rstd_ = rsqrtf(wave_sum(ss_) * (1.f / D) + EPS); _Pragma("unroll") for (int j = 0; j < 8; ++j) { const f32x4 y = v_[j] * rstd_ * A_[j] + B_[j]; \
        int w8 = 0; w8 = __builtin_amdgcn_cvt_pk_fp8_f32(y[0], y[1], w8, false); w8 = __builtin_amdgcn_cvt_pk_fp8_f32(y[2], y[3], w8, true); *(int*)((o_) + 256 * j) = w8; } } while (0)
__device__ __forceinline__ void norm_rows(const float* __restrict__ X, int nrows, const float* __restrict__ gain, const long long* __restrict__ mod, int shift_off, int scale_off, int fixed_mod_row, unsigned char* __restrict__ out, int gw, int NGW, int lane) {
    for (int ra = gw; ra < nrows; ra += 2 * NGW) {
        const int rb = ra + NGW; const bool hb = rb < nrows;
        const float* x0 = X + (size_t)ra * D + lane * 4; const float* x1 = X + (size_t)(hb ? rb : ra) * D + lane * 4;
        f32x4 v0[8], v1[8]; float s0 = 0.f, s1 = 0.f;
#pragma unroll
        for (int j = 0; j < 8; ++j) v0[j] = *(const f32x4*)(x0 + 256 * j);
#pragma unroll
        for (int j = 0; j < 8; ++j) v1[j] = *(const f32x4*)(x1 + 256 * j);
        const int ma = fixed_mod_row >= 0 ? fixed_mod_row : (ra >> 12), mb = fixed_mod_row >= 0 ? fixed_mod_row : (rb >> 12);
        f32x4 A_[8], B_[8];
        NORM_AB(gain, mod + (size_t)ma * MODW + lane * 4, scale_off, shift_off);
#pragma unroll
        for (int j = 0; j < 8; ++j) { s0 += (v0[j][0] * v0[j][0] + v0[j][1] * v0[j][1]) + (v0[j][2] * v0[j][2] + v0[j][3] * v0[j][3]); s1 += (v1[j][0] * v1[j][0] + v1[j][1] * v1[j][1]) + (v1[j][2] * v1[j][2] + v1[j][3] * v1[j][3]); }
        NORM_OUT8(v0, s0, out + (size_t)ra * D + lane * 4);
        if (hb) { if (mb != ma) NORM_AB(gain, mod + (size_t)mb * MODW + lane * 4, scale_off, shift_off);
            NORM_OUT8(v1, s1, out + (size_t)rb * D + lane * 4); }
    }
}
#undef NORM_OUT8

#define NORM_CVT(v_, w_, ss_) do { _Pragma("unroll") for (int j = 0; j < 8; ++j) { \
        v_[j] = (f32x4){__uint_as_float(w_[j].x << 16), __uint_as_float(w_[j].x & 0xffff0000u), __uint_as_float(w_[j].y << 16), __uint_as_float(w_[j].y & 0xffff0000u)}; \
        ss_ += (v_[j][0] * v_[j][0] + v_[j][1] * v_[j][1]) + (v_[j][2] * v_[j][2] + v_[j][3] * v_[j][3]); } } while (0)
__device__ __forceinline__ void norm_rows_bf16(const bf16* __restrict__ X, int nrows, const float* __restrict__ gain, const long long* __restrict__ mod, int shift_off, int scale_off, bf16* __restrict__ out, int gw, int NGW, int lane) {
    for (int ra = gw; ra < nrows; ra += 4 * NGW) {
        const int rb = ra + NGW, rc = ra + 2 * NGW, rd = ra + 3 * NGW; const bool hb = rb < nrows, hc = rc < nrows, hd = rd < nrows;
        u32x2 w0[8], w1[8], w2[8], w3[8];
        { const bf16* x0 = X + (size_t)ra * D + lane * 4; const bf16* x1 = X + (size_t)(hb ? rb : ra) * D + lane * 4; const bf16* x2 = X + (size_t)(hc ? rc : ra) * D + lane * 4; const bf16* x3 = X + (size_t)(hd ? rd : ra) * D + lane * 4;
#pragma unroll
          for (int j = 0; j < 8; ++j) w0[j] = *(const u32x2*)(x0 + 256 * j);
#pragma unroll
          for (int j = 0; j < 8; ++j) w1[j] = *(const u32x2*)(x1 + 256 * j);
#pragma unroll
          for (int j = 0; j < 8; ++j) w2[j] = *(const u32x2*)(x2 + 256 * j);
#pragma unroll
          for (int j = 0; j < 8; ++j) w3[j] = *(const u32x2*)(x3 + 256 * j); }
        f32x4 A_[8], B_[8]; f32x4 v_[8]; float ss;
        int mcur = ra >> 12;
        NORM_AB(gain, mod + (size_t)mcur * MODW + lane * 4, scale_off, shift_off);
        ss = 0.f; NORM_CVT(v_, w0, ss); NORM_OUT(v_, ss, out + (size_t)ra * D + lane * 4);
        if (hb) { if ((rb >> 12) != mcur) { mcur = rb >> 12; NORM_AB(gain, mod + (size_t)mcur * MODW + lane * 4, scale_off, shift_off); }
            ss = 0.f; NORM_CVT(v_, w1, ss); NORM_OUT(v_, ss, out + (size_t)rb * D + lane * 4); }
        if (hc) { if ((rc >> 12) != mcur) { mcur = rc >> 12; NORM_AB(gain, mod + (size_t)mcur * MODW + lane * 4, scale_off, shift_off); }
            ss = 0.f; NORM_CVT(v_, w2, ss); NORM_OUT(v_, ss, out + (size_t)rc * D + lane * 4); }
        if (hd) { if ((rd >> 12) != mcur) { mcur = rd >> 12; NORM_AB(gain, mod + (size_t)mcur * MODW + lane * 4, scale_off, shift_off); }
            ss = 0.f; NORM_CVT(v_, w3, ss); NORM_OUT(v_, ss, out + (size_t)rd * D + lane * 4); }
    }
}
#undef NORM_CVT
#undef NORM_AB
#undef NORM_OUT


#define XB_TMO      128
#define XB_XCNT(j)  (256  + 64 * (j))
#define XB_XSUB(j)  (1280 + 64 * (j))
#define XB_XGEN(j)  (2304 + 64 * (j))
#define XB_TOP      3328
#define XB_TOPGEN   3392
#define XCD_BAR_WORDS 3456
#define XB_SPIN_CAP (1u << 18)

__device__ __forceinline__ unsigned xb_ld(unsigned* p)              { return __hip_atomic_load(p, __ATOMIC_RELAXED, __HIP_MEMORY_SCOPE_AGENT); }
__device__ __forceinline__ unsigned xb_add(unsigned* p, unsigned v) { return __hip_atomic_fetch_add(p, v, __ATOMIC_RELAXED, __HIP_MEMORY_SCOPE_AGENT); }
__device__ __forceinline__ unsigned xb_xcc_id() { return (unsigned)__builtin_amdgcn_s_getreg((3 << 11) | 20) & 0xFu; }
#define XB_SPIN(cond, bar) do { unsigned _sp = 0; while (cond) { __builtin_amdgcn_s_sleep(1); \
    if ((++_sp & 255u) == 0u) { if (xb_ld(&(bar)[XB_TMO])) break; if (_sp > XB_SPIN_CAP) { atomicAdd(&(bar)[XB_TMO], 1u); break; } } } } while (0)

struct XcdBarrier {
    unsigned* bar; unsigned x;
    volatile LAS unsigned* st;
};

__device__ __forceinline__ XcdBarrier xcd_barrier_post(unsigned* bar, volatile LAS unsigned* st) {
    XcdBarrier b; b.bar = bar; b.x = xb_xcc_id(); b.st = st;
    if (threadIdx.x == 0) (void)xb_add(&bar[XB_XCNT(b.x)], 1u);
    return b;
}
__device__ __forceinline__ void xcd_barrier_complete(unsigned* bar, unsigned x, unsigned& nloc, unsigned& nx) {
    const unsigned G = gridDim.x * gridDim.y * gridDim.z;
    unsigned sum, cnt, mine, sp = 0u;
    for (;;) {
        sum = 0u; cnt = 0u; mine = 0u;
#pragma unroll
        for (unsigned j = 0; j < 16; ++j) { const unsigned c = xb_ld(&bar[XB_XCNT(j)]); sum += c; cnt += (c > 0u) ? 1u : 0u; mine = (j == x) ? c : mine; }
        if (sum == G) break;
        __builtin_amdgcn_s_sleep(1);
        if ((++sp & 255u) == 0u) { if (xb_ld(&bar[XB_TMO])) break; if (sp > XB_SPIN_CAP) { atomicAdd(&bar[XB_TMO], 1u); break; } }
    }
    nloc = mine > 0u ? mine : 1u; nx = cnt > 0u ? cnt : 1u;
}

__device__ __forceinline__ void xcd_barrier(const XcdBarrier& b) {
    asm volatile("s_waitcnt vmcnt(0)" ::: "memory");
    __syncthreads();
    if (threadIdx.x == 0) {
        unsigned* bar = b.bar;
        __builtin_amdgcn_s_waitcnt(0);
        unsigned nloc = b.st[0], nx = b.st[1];
        if (nloc == 0u) { xcd_barrier_complete(bar, b.x, nloc, nx); b.st[0] = nloc; b.st[1] = nx; }
        const unsigned old = xb_add(&bar[XB_XSUB(b.x)], 1u);
        const unsigned gen = old / nloc;
        if (old + 1u == (gen + 1u) * nloc) {
            __builtin_amdgcn_fence(__ATOMIC_RELEASE, "agent");
            asm volatile("s_waitcnt vmcnt(0)" ::: "memory");
            const unsigned og = xb_add(&bar[XB_TOP], 1u);
            const unsigned tg = og / nx;
            if (og + 1u == (tg + 1u) * nx) xb_add(&bar[XB_TOPGEN], 1u);
            else XB_SPIN(xb_ld(&bar[XB_TOPGEN]) == tg, bar);
            __builtin_amdgcn_fence(__ATOMIC_ACQUIRE, "agent");
            xb_add(&bar[XB_XGEN(b.x)], 1u);
            asm volatile("s_waitcnt vmcnt(0)" ::: "memory");
        } else {
            XB_SPIN(xb_ld(&bar[XB_XGEN(b.x)]) == gen, bar);
            __builtin_amdgcn_fence(__ATOMIC_ACQUIRE, "agent");
            asm volatile("s_waitcnt vmcnt(0)" ::: "memory");
        }
    }
    __syncthreads();
}

typedef float f32x16 __attribute__((ext_vector_type(16)));
typedef short s16x8 __attribute__((ext_vector_type(8)));
typedef short s16x4 __attribute__((ext_vector_type(4)));
__device__ __forceinline__ int crow(int r, int hi) { return (r & 3) + 8 * (r >> 2) + 4 * hi; }
__device__ __forceinline__ s16x4 vtr(LAS const unsigned char* p) { return __builtin_bit_cast(s16x4, __builtin_amdgcn_ds_read_tr16_b64_v4i16((LAS s16x4*)p)); }
typedef float att_f32x2 __attribute__((ext_vector_type(2))); typedef __bf16 att_bf16x2 __attribute__((ext_vector_type(2)));
__device__ __forceinline__ unsigned cvtpk(float lo, float hi) { const att_f32x2 v = {lo, hi}; const att_bf16x2 b = __builtin_convertvector(v, att_bf16x2); return __builtin_bit_cast(unsigned, b); }
constexpr float ATT_C2 = 0.125f * 1.4426950408889634f;

__device__ __forceinline__ float max3f(float a, float b, float c) { float r; asm("v_max3_f32 %0, %1, %2, %3" : "=v"(r) : "v"(a), "v"(b), "v"(c)); return r; }
__device__ __forceinline__ float max2f(float a, float b) { float r; asm("v_max_f32 %0, %1, %2" : "=v"(r) : "v"(a), "v"(b)); return r; }
__device__ __forceinline__ float max16(const f32x16& p) {
    float ra, rb;
    asm volatile("v_max3_f32 %0, %2, %3, %4\n\tv_max3_f32 %1, %10, %11, %12\n\tv_max3_f32 %0, %0, %5, %6\n\tv_max3_f32 %1, %1, %13, %14\n\t"
                 "v_max3_f32 %0, %0, %7, %8\n\tv_max3_f32 %1, %1, %15, %16\n\tv_max_f32 %0, %0, %9\n\tv_max_f32 %1, %1, %17\n\tv_max_f32 %0, %0, %1"
                 : "=&v"(ra), "=&v"(rb) : "v"(p[0]), "v"(p[1]), "v"(p[2]), "v"(p[3]), "v"(p[4]), "v"(p[5]), "v"(p[6]), "v"(p[7]), "v"(p[8]), "v"(p[9]), "v"(p[10]), "v"(p[11]), "v"(p[12]), "v"(p[13]), "v"(p[14]), "v"(p[15]));
    return ra;
}
template <int NBLK> struct RowSt { f32x16 o[NBLK]; f32x16 negm; float m, l; s16x8 q[4]; };

#define ATT_VREAD(buf, blk) do { _Pragma("unroll") for (int ks_ = 0; ks_ < 4; ++ks_) { buf[2 * ks_] = vtr(vbp + (blk) * 4096 + ks_ * 1024); buf[2 * ks_ + 1] = vtr(vbp + (blk) * 4096 + ks_ * 1024 + 512); } } while (0)
#define ATT_PV(buf, blk) do { _Pragma("unroll") for (int ks_ = 0; ks_ < 4; ++ks_) { const s16x4 lo_ = buf[2 * ks_], hh_ = buf[2 * ks_ + 1]; \
        const s16x8 vf_ = {lo_[0], lo_[1], lo_[2], lo_[3], hh_[0], hh_[1], hh_[2], hh_[3]}; \
        st.o[blk] = __builtin_amdgcn_mfma_f32_32x32x16_bf16(__builtin_bit_cast(s16x8, pw[ks_]), vf_, st.o[blk], 0, 0, 0); } } while (0)
template <int NBLK, bool MASK, int BOFF>
__device__ __forceinline__ void attn_tile(RowSt<NBLK>& st, LAS const unsigned char* Kt, LAS const unsigned char* Vt, LAS float* wsf, int r32, int hi, int lane, int qpos, int kpos0, bool first) {
    s16x8 kf[8];
#pragma unroll
    for (int d0 = 0; d0 < 4; ++d0) { const int c = 2 * d0 + hi; LAS const unsigned char* kp = Kt + BOFF + c * 1024 + ((r32 ^ c) << 4);
        kf[2 * d0] = *(LAS const s16x8*)kp; kf[2 * d0 + 1] = *(LAS const s16x8*)(kp + 512); }
    LAS const unsigned char* vbp = Vt + BOFF + ((lane >> 4) & 1) * 32 + (lane & 3) * 8 + (4 * hi + ((lane & 15) >> 2)) * 64;
    s16x4 va[8], vb[8];
#pragma unroll
    for (int bl_ = 0; bl_ < NBLK; ++bl_) { va[2 * bl_] = vtr(vbp + bl_ * 4096); va[2 * bl_ + 1] = vtr(vbp + bl_ * 4096 + 512); }
    __builtin_amdgcn_sched_barrier(0);
    f32x16 p0, p1;
    p0 = __builtin_amdgcn_mfma_f32_32x32x16_bf16(kf[0], st.q[0], st.negm, 0, 0, 0);
    p1 = __builtin_amdgcn_mfma_f32_32x32x16_bf16(kf[1], st.q[0], st.negm, 0, 0, 0);
#pragma unroll
    for (int d0 = 1; d0 < 4; ++d0) {
        p0 = __builtin_amdgcn_mfma_f32_32x32x16_bf16(kf[2 * d0], st.q[d0], p0, 0, 0, 0);
        p1 = __builtin_amdgcn_mfma_f32_32x32x16_bf16(kf[2 * d0 + 1], st.q[d0], p1, 0, 0, 0);
    }
    if (MASK) {
        asm volatile("s_nop 15\n\ts_nop 7" : "+v"(p0), "+v"(p1));
#pragma unroll
        for (int r = 0; r < 16; ++r) { const int d = qpos - (kpos0 + crow(r, hi)); if (d > 128 || d < -128) p0[r] = -1.0e30f; const int d2 = d - 32; if (d2 > 128 || d2 < -128) p1[r] = -1.0e30f; }
    } else {
        asm volatile("s_nop 7" : "+v"(p0), "+v"(p1));
    }
    const float rm0_ = max16(p0); const float rm1_ = max16(p1);
    float rm = max2f(rm0_, rm1_);
    { const unsigned x_ = __float_as_uint(rm); auto rr_ = __builtin_amdgcn_permlane32_swap(x_, x_, false, false); rm = max2f(__uint_as_float(rr_[0]), __uint_as_float(rr_[1])); }
    if (first || __any(rm > 8.f)) {
        const float dl = first ? rm : fmaxf(rm, 0.f); const float alpha = __builtin_amdgcn_exp2f(-dl); st.m += dl; st.l *= alpha;
#pragma unroll
        for (int r = 0; r < 16; ++r) { p0[r] -= dl; p1[r] -= dl; st.negm[r] = -st.m; }
        if (hi == 0) wsf[r32] = alpha;
#pragma unroll
        for (int g = 0; g < 4; ++g) { const f32x4 a4 = *(LAS const f32x4*)(wsf + 8 * g + 4 * hi);
#pragma unroll
            for (int j = 0; j < 4; ++j)
#pragma unroll
                for (int blk = 0; blk < NBLK; ++blk) st.o[blk][4 * g + j] *= a4[j]; }
    }
    float sq0 = 0.f, sq1 = 0.f;
    u32x4 pw[4];
#define ATT_FILL(PV_, base, s, g) do { const float ea_ = __builtin_amdgcn_exp2f(PV_[(base) + 2 * (g)]), eb_ = __builtin_amdgcn_exp2f(PV_[(base) + 2 * (g) + 1]); \
        sq0 += ea_; sq1 += eb_; pw[s][g] = cvtpk(ea_, eb_); } while (0)
#define ATT_VREAD_KS(buf, ks) do { _Pragma("unroll") for (int bl_ = 0; bl_ < NBLK; ++bl_) { buf[2 * bl_] = vtr(vbp + bl_ * 4096 + (ks) * 1024); buf[2 * bl_ + 1] = vtr(vbp + bl_ * 4096 + (ks) * 1024 + 512); } } while (0)
#define ATT_MFMA1(buf, ks, bl_) do { const s16x4 lo_ = buf[2 * (bl_)], hh_ = buf[2 * (bl_) + 1]; \
        const s16x8 vf_ = {lo_[0], lo_[1], lo_[2], lo_[3], hh_[0], hh_[1], hh_[2], hh_[3]}; \
        st.o[bl_] = __builtin_amdgcn_mfma_f32_32x32x16_bf16(__builtin_bit_cast(s16x8, pw[ks]), vf_, st.o[bl_], 0, 0, 0); } while (0)
    ATT_FILL(p0, 0, 0, 0); ATT_FILL(p0, 0, 0, 1); ATT_FILL(p0, 0, 0, 2); ATT_FILL(p0, 0, 0, 3);
    __builtin_amdgcn_sched_barrier(0);
    ATT_VREAD_KS(vb, 1);
    __builtin_amdgcn_sched_barrier(0);
    if (NBLK == 4) {
        ATT_MFMA1(va, 0, 0); ATT_FILL(p0, 8, 1, 0); __builtin_amdgcn_sched_barrier(0);
        ATT_MFMA1(va, 0, 1); ATT_FILL(p0, 8, 1, 1); __builtin_amdgcn_sched_barrier(0);
        ATT_MFMA1(va, 0, 2); ATT_FILL(p0, 8, 1, 2); __builtin_amdgcn_sched_barrier(0);
        ATT_MFMA1(va, 0, 3); ATT_FILL(p0, 8, 1, 3); __builtin_amdgcn_sched_barrier(0);
        ATT_VREAD_KS(va, 2);
        __builtin_amdgcn_sched_barrier(0);
        ATT_MFMA1(vb, 1, 0); ATT_FILL(p1, 0, 2, 0); __builtin_amdgcn_sched_barrier(0);
        ATT_MFMA1(vb, 1, 1); ATT_FILL(p1, 0, 2, 1); __builtin_amdgcn_sched_barrier(0);
        ATT_MFMA1(vb, 1, 2); ATT_FILL(p1, 0, 2, 2); __builtin_amdgcn_sched_barrier(0);
        ATT_MFMA1(vb, 1, 3); ATT_FILL(p1, 0, 2, 3); __builtin_amdgcn_sched_barrier(0);
        ATT_VREAD_KS(vb, 3);
        __builtin_amdgcn_sched_barrier(0);
        ATT_MFMA1(va, 2, 0); ATT_FILL(p1, 8, 3, 0); __builtin_amdgcn_sched_barrier(0);
        ATT_MFMA1(va, 2, 1); ATT_FILL(p1, 8, 3, 1); __builtin_amdgcn_sched_barrier(0);
        ATT_MFMA1(va, 2, 2); ATT_FILL(p1, 8, 3, 2); __builtin_amdgcn_sched_barrier(0);
        ATT_MFMA1(va, 2, 3); ATT_FILL(p1, 8, 3, 3); __builtin_amdgcn_sched_barrier(0);
        ATT_MFMA1(vb, 3, 0); ATT_MFMA1(vb, 3, 1); ATT_MFMA1(vb, 3, 2); ATT_MFMA1(vb, 3, 3);
    } else {
        ATT_MFMA1(va, 0, 0); ATT_FILL(p0, 8, 1, 0); ATT_FILL(p0, 8, 1, 1); __builtin_amdgcn_sched_barrier(0);
        ATT_MFMA1(va, 0, 1); ATT_FILL(p0, 8, 1, 2); ATT_FILL(p0, 8, 1, 3); __builtin_amdgcn_sched_barrier(0);
        ATT_VREAD_KS(va, 2);
        __builtin_amdgcn_sched_barrier(0);
        ATT_MFMA1(vb, 1, 0); ATT_FILL(p1, 0, 2, 0); ATT_FILL(p1, 0, 2, 1); __builtin_amdgcn_sched_barrier(0);
        ATT_MFMA1(vb, 1, 1); ATT_FILL(p1, 0, 2, 2); ATT_FILL(p1, 0, 2, 3); __builtin_amdgcn_sched_barrier(0);
        ATT_VREAD_KS(vb, 3);
        __builtin_amdgcn_sched_barrier(0);
        ATT_MFMA1(va, 2, 0); ATT_FILL(p1, 8, 3, 0); ATT_FILL(p1, 8, 3, 1); __builtin_amdgcn_sched_barrier(0);
        ATT_MFMA1(va, 2, 1); ATT_FILL(p1, 8, 3, 2); ATT_FILL(p1, 8, 3, 3); __builtin_amdgcn_sched_barrier(0);
        ATT_MFMA1(vb, 3, 0); ATT_MFMA1(vb, 3, 1);
    }
    st.l += sq0 + sq1;
#undef ATT_FILL
#undef ATT_VREAD_KS
#undef ATT_MFMA1
}
__device__ __forceinline__ unsigned char f2fp8(float v) { return (unsigned char)(__builtin_amdgcn_cvt_pk_fp8_f32(v, 0.f, 0, false) & 0xff); }
typedef int att_v8i __attribute__((ext_vector_type(8)));
typedef int att_v2i __attribute__((ext_vector_type(2)));
__device__ __forceinline__ att_v2i vtr8(LAS const unsigned char* p) { return __builtin_amdgcn_ds_read_tr8_b64_v2i32((LAS att_v2i*)p); }
template <int NBLK, bool MASK, int BOFF>
__device__ __forceinline__ void attn_tile8(RowSt<NBLK>& st, LAS const unsigned char* Kt, LAS const unsigned char* Vt, LAS float* wsf, int r32, int hi, int lane, int qpos, int kpos0, bool first) {
    u32x4 ka0, ka1, kb0, kb1;
    { const int c = 2 * hi; LAS const unsigned char* kp = Kt + BOFF + c * 1024 + ((r32 ^ c) << 4), *kq = Kt + BOFF + (c + 1) * 1024 + ((r32 ^ (c + 1)) << 4);
      ka0 = *(LAS const u32x4*)kp; kb0 = *(LAS const u32x4*)(kp + 512); ka1 = *(LAS const u32x4*)kq; kb1 = *(LAS const u32x4*)(kq + 512); }
    const int rho = (lane & 15) >> 1;
    constexpr int VR = 32 * NBLK;
    const int lkey = 4 * hi + (rho & 3) + 8 * (rho >> 2), sw = NBLK == 4 ? (((rho >> 1) & 1) | (((rho >> 2) & 1) << 1)) : ((rho >> 2) & 1);
    LAS const unsigned char* vb_ = Vt + BOFF + lkey * VR + 16 * ((lane >> 4) & 1) + 8 * (lane & 1);
    __builtin_amdgcn_sched_barrier(0);
    f32x16 p0, p1;
    {
        const att_v8i q8 = {(int)__builtin_bit_cast(u32x4, st.q[0]).x, (int)__builtin_bit_cast(u32x4, st.q[0]).y, (int)__builtin_bit_cast(u32x4, st.q[0]).z, (int)__builtin_bit_cast(u32x4, st.q[0]).w,
                            (int)__builtin_bit_cast(u32x4, st.q[1]).x, (int)__builtin_bit_cast(u32x4, st.q[1]).y, (int)__builtin_bit_cast(u32x4, st.q[1]).z, (int)__builtin_bit_cast(u32x4, st.q[1]).w};
        const att_v8i k0 = {(int)ka0.x, (int)ka0.y, (int)ka0.z, (int)ka0.w, (int)ka1.x, (int)ka1.y, (int)ka1.z, (int)ka1.w};
        const att_v8i k1 = {(int)kb0.x, (int)kb0.y, (int)kb0.z, (int)kb0.w, (int)kb1.x, (int)kb1.y, (int)kb1.z, (int)kb1.w};
        p0 = __builtin_amdgcn_mfma_scale_f32_32x32x64_f8f6f4(k0, q8, st.negm, 0, 0, 0, 0x7f7f7f7f, 0, 0x7c7c7c7c);
        p1 = __builtin_amdgcn_mfma_scale_f32_32x32x64_f8f6f4(k1, q8, st.negm, 0, 0, 0, 0x7f7f7f7f, 0, 0x7c7c7c7c);
    }
    __builtin_amdgcn_sched_barrier(0);
    att_v2i vf[NBLK][4];
#pragma unroll
    for (int blk = 0; blk < NBLK; ++blk)
#pragma unroll
        for (int q = 0; q < 4; ++q) vf[blk][q] = vtr8(vb_ + ((blk ^ sw) * 32) + (q & 1) * (16 * VR) + (q >> 1) * (32 * VR));
    __builtin_amdgcn_sched_barrier(0);
    if (MASK) {
        asm volatile("s_nop 15\n\ts_nop 7" : "+v"(p0), "+v"(p1));
#pragma unroll
        for (int r = 0; r < 16; ++r) { const int d = qpos - (kpos0 + crow(r, hi)); if (d > 128 || d < -128) p0[r] = -1.0e30f; const int d2 = d - 32; if (d2 > 128 || d2 < -128) p1[r] = -1.0e30f; }
    } else
    asm volatile("s_nop 7" : "+v"(p0), "+v"(p1));
    const float rm0_ = max16(p0); const float rm1_ = max16(p1);
    float rm = max2f(rm0_, rm1_);
    { const unsigned x_ = __float_as_uint(rm); auto rr_ = __builtin_amdgcn_permlane32_swap(x_, x_, false, false); rm = max2f(__uint_as_float(rr_[0]), __uint_as_float(rr_[1])); }
    if (first || __any(rm > 8.f)) {
        const float dl = first ? rm : fmaxf(rm, 0.f); const float alpha = __builtin_amdgcn_exp2f(-dl); st.m += dl; st.l *= alpha;
#pragma unroll
        for (int r = 0; r < 16; ++r) { p0[r] -= dl; p1[r] -= dl; st.negm[r] = -st.m; }
        if (hi == 0) wsf[r32] = alpha;
#pragma unroll
        for (int g = 0; g < 4; ++g) { const f32x4 a4 = *(LAS const f32x4*)(wsf + 8 * g + 4 * hi);
#pragma unroll
            for (int j = 0; j < 4; ++j)
#pragma unroll
                for (int blk = 0; blk < NBLK; ++blk) st.o[blk][4 * g + j] *= a4[j]; }
    }
    float sq0 = 0.f, sq1 = 0.f;
    att_v8i pa;
#pragma unroll
    for (int d = 0; d < 4; ++d) {
        const float e0 = __builtin_amdgcn_exp2f(p0[4 * d]), e1 = __builtin_amdgcn_exp2f(p0[4 * d + 1]), e2 = __builtin_amdgcn_exp2f(p0[4 * d + 2]), e3 = __builtin_amdgcn_exp2f(p0[4 * d + 3]);
        const float f0 = __builtin_amdgcn_exp2f(p1[4 * d]), f1 = __builtin_amdgcn_exp2f(p1[4 * d + 1]), f2 = __builtin_amdgcn_exp2f(p1[4 * d + 2]), f3 = __builtin_amdgcn_exp2f(p1[4 * d + 3]);
        sq0 += (e0 + e1) + (e2 + e3); sq1 += (f0 + f1) + (f2 + f3);
        int wa, wb; asm volatile("" : "=v"(wa), "=v"(wb));
        wa = __builtin_amdgcn_cvt_pk_fp8_f32(e0, e1, wa, false); wa = __builtin_amdgcn_cvt_pk_fp8_f32(e2, e3, wa, true);
        wb = __builtin_amdgcn_cvt_pk_fp8_f32(f0, f1, wb, false); wb = __builtin_amdgcn_cvt_pk_fp8_f32(f2, f3, wb, true);
        pa[d] = wa; pa[4 + d] = wb;
    }
    st.l += sq0 + sq1;
#pragma unroll
    for (int blk = 0; blk < NBLK; ++blk) {
        const att_v8i vb8 = {vf[blk][0].x, vf[blk][0].y, vf[blk][1].x, vf[blk][1].y, vf[blk][2].x, vf[blk][2].y, vf[blk][3].x, vf[blk][3].y};
        st.o[blk] = __builtin_amdgcn_mfma_scale_f32_32x32x64_f8f6f4(pa, vb8, st.o[blk], 0, 0, 0, 0x7f7f7f7f, 0, 0x7f7f7f7f);
    }
}
template <int NBLK>
__device__ __forceinline__ void attn_finish(RowSt<NBLK>& st, LAS float* wsf, int r32, int hi) {
    const float lt = st.l + xchg32(st.l);
    if (hi == 0) wsf[r32] = 1.f / lt;
#pragma unroll
    for (int g = 0; g < 4; ++g) { const f32x4 a4 = *(LAS const f32x4*)(wsf + 8 * g + 4 * hi);
#pragma unroll
        for (int j = 0; j < 4; ++j)
#pragma unroll
            for (int blk = 0; blk < NBLK; ++blk) st.o[blk][4 * g + j] *= a4[j]; }
}
__device__ __forceinline__ float half_sum32(float v) {
#pragma unroll
    for (int o = 1; o < 32; o <<= 1) v += __shfl_xor(v, o);
    return v;
}

__device__ __forceinline__ void diff_unit(const unsigned char* __restrict__ Q8, const unsigned char* __restrict__ K8, const unsigned char* __restrict__ V8, const float* __restrict__ diff_norm, float lam, bf16* __restrict__ AO, LAS unsigned char* lds, int b, int h, int qb, int tid, int wave, int lane) {
    const int r32 = lane & 31, hi = lane >> 5, map = wave >> 2, rg = (wave & 3) * 32;
    LAS float* wsf = (LAS float*)(lds + RING_BYTES) + wave * 64;
    LAS float* X = (LAS float*)(lds + 65536);
    RowSt<4> st;
    { const unsigned char* qp = Q8 + (size_t)(b * S + qb * 128 + rg + r32) * 1024 + h * 128 + map * 64 + hi * 32;
      st.q[0] = *(const s16x8*)qp; st.q[1] = *(const s16x8*)(qp + 16); }
#pragma unroll
    for (int blk = 0; blk < 4; ++blk)
#pragma unroll
        for (int r = 0; r < 16; ++r) st.o[blk][r] = 0.f;
    st.m = 0.f; st.l = 0.f;
#pragma unroll
    for (int r = 0; r < 16; ++r) st.negm[r] = 0.f;
    const int kr = tid >> 3, kc = tid & 7;
    const unsigned koff = (kc >> 2) * 4096 + (kc & 3) * 1024 + ((kr ^ (kc & 3)) << 4);
    const int NT = (CL + S) / 64;
    u32x4 gk1, gv0;
    const unsigned voff = kr * 128 + ((((unsigned)kc >> 1) ^ ((((unsigned)kr >> 1) & 1u) | ((((unsigned)kr >> 3) & 1u) << 1))) * 32) + (kc & 1) * 16;
#define DROWBASE(t) ((t) < 4 ? (size_t)(M + b * CL + (t) * 64) : (size_t)(b * S + ((t) - 4) * 64))
    const unsigned vgo = (unsigned)(kr * 1024 + kc * 16);
#define gload(t) do { const size_t rb_ = DROWBASE(t) * 1024 + h * 128; gk1 = *(const u32x4*)(K8 + rb_ + vgo); gv0 = *(const u32x4*)(V8 + rb_ + vgo); } while (0)
#define lwrite(buf) do { LAS unsigned char* bp_ = lds + (buf) * 32768; *(LAS u32x4*)(bp_ + koff) = gk1; *(LAS u32x4*)(bp_ + 16384 + voff) = gv0; } while (0)
    gload(0); lwrite(0);
    __syncthreads();
    LAS const unsigned char* kbase = lds + map * 4096;
#pragma unroll 1
    for (int t = 0; t < NT; t += 2) {
        gload(t + 1);
        attn_tile8<4, false, 0>(st, kbase, lds + 16384, wsf, r32, hi, lane, 0, 0, t == 0);
        lwrite(1);
        __syncthreads();
        if (t + 2 < NT) gload(t + 2);
        attn_tile8<4, false, 32768>(st, kbase, lds + 16384, wsf, r32, hi, lane, 0, 0, false);
        if (t + 2 < NT) lwrite(0);
        __syncthreads();
    }
    attn_finish<4>(st, wsf, r32, hi);
    if (map == 1) {
#pragma unroll
        for (int blk = 0; blk < 4; ++blk)
#pragma unroll
            for (int r = 0; r < 16; ++r) X[(((wave & 3) * 4 + blk) * 16 + r) * 64 + lane] = st.o[blk][r] * lam;
    }
    __syncthreads();
    if (map == 0) {
        const float gn0 = diff_norm[h * 128 + r32], gn1 = diff_norm[h * 128 + 32 + r32], gn2 = diff_norm[h * 128 + 64 + r32], gn3 = diff_norm[h * 128 + 96 + r32];
        LAS const float* Xw = X + (wave & 3) * 4096 + lane;
#pragma unroll
        for (int r = 0; r < 16; ++r) {
            const float v0 = st.o[0][r] - Xw[(0 * 16 + r) * 64], v1 = st.o[1][r] - Xw[(1 * 16 + r) * 64], v2 = st.o[2][r] - Xw[(2 * 16 + r) * 64], v3 = st.o[3][r] - Xw[(3 * 16 + r) * 64];
            const float rinv = rsqrtf(half_sum32((v0 * v0 + v1 * v1) + (v2 * v2 + v3 * v3)) * (1.f / 128.f) + EPS) * 0.8f;
            unsigned char* op = (unsigned char*)AO + (size_t)(b * S + qb * 128 + rg + crow(r, hi)) * D + h * 128 + r32;
            op[0] = f2fp8(v0 * rinv * gn0); op[32] = f2fp8(v1 * rinv * gn1); op[64] = f2fp8(v2 * rinv * gn2); op[96] = f2fp8(v3 * rinv * gn3);
        }
    }
}
#undef gload
#undef lwrite
#undef DROWBASE
__device__ __forceinline__ void swa_unit(const unsigned char* __restrict__ SQ8, const unsigned char* __restrict__ SK8, const unsigned char* __restrict__ SV8, const float* __restrict__ sink, const float* __restrict__ swa_norm, bf16* __restrict__ AO, LAS unsigned char* lds, int b, int kvh, int hb, int tid, int wave, int lane) {
    const int r32 = lane & 31, hi = lane >> 5, head = kvh * 4 + (wave >> 1), rbase = hb * 64 + (wave & 1) * 32;
    LAS float* wsf = (LAS float*)(lds + RING_BYTES) + wave * 64;
    RowSt<2> st;
    {
        const unsigned char* qp = SQ8 + (size_t)(b * S + rbase + r32) * 1024 + head * 64 + hi * 32;
        st.q[0] = *(const s16x8*)qp; st.q[1] = *(const s16x8*)(qp + 16);
#pragma unroll
        for (int blk = 0; blk < 2; ++blk)
#pragma unroll
            for (int r = 0; r < 16; ++r) st.o[blk][r] = 0.f;
        st.m = sink[head] * 1.4426950408889634f; st.l = hi == 0 ? 1.f : 0.f;
#pragma unroll
        for (int r = 0; r < 16; ++r) st.negm[r] = -st.m;
    }
    const int kr = (tid & 255) >> 2, kc = tid & 3; const bool isv = tid >= 256;
    const unsigned koff = isv ? 8192u + kr * 64 + (((unsigned)(kc >> 1) ^ (((unsigned)kr >> 3) & 1u)) * 32) + (kc & 1) * 16 : (unsigned)(kc * 1024 + ((kr ^ kc) << 4));
    const int klo = hb - 2 < 0 ? 0 : hb - 2, khi = hb + 2 > S / 64 - 1 ? S / 64 - 1 : hb + 2;
    const int NT = 4 + (khi - klo + 1);
    u32x4 gk;
    const unsigned char* const src8 = isv ? SV8 : SK8;
#define SROWBASE(t) ((t) < 4 ? (size_t)(M + b * CL + (t) * 64) : (size_t)(b * S + (klo + (t) - 4) * 64))
#define gload(t) do { gk = *(const u32x4*)(src8 + (SROWBASE(t) + kr) * 256 + kvh * 64 + kc * 16); } while (0)
#define lwrite(buf) do { *(LAS u32x4*)(lds + (buf) * 16384 + koff) = gk; } while (0)
    gload(0); lwrite(0);
    __syncthreads();
    const int qpos = rbase + r32;
#define SWA_STEP(t_, BO, nb) do { if ((t_) + 1 < NT) gload((t_) + 1); \
        if ((t_) < 4) attn_tile8<2, false, BO>(st, lds, lds + 8192, wsf, r32, hi, lane, 0, 0, false); \
        else attn_tile8<2, true, BO>(st, lds, lds + 8192, wsf, r32, hi, lane, qpos, (klo + (t_) - 4) * 64, false); \
        if ((t_) + 1 < NT) lwrite(nb); \
        __syncthreads(); } while (0)
    int t = 0;
#pragma unroll 1
    for (; t + 1 < NT; t += 2) { SWA_STEP(t, 0, 1); SWA_STEP(t + 1, 16384, 0); }
    if (t < NT) SWA_STEP(t, 0, 1);
#undef SWA_STEP
#undef gload
#undef lwrite
#undef SROWBASE
    const float gn0 = swa_norm[head * 64 + r32], gn1 = swa_norm[head * 64 + 32 + r32];
    attn_finish<2>(st, wsf, r32, hi);
#pragma unroll
    for (int r = 0; r < 16; ++r) {
        const float v0 = st.o[0][r], v1 = st.o[1][r];
        const float rinv = rsqrtf(half_sum32(v0 * v0 + v1 * v1) * (1.f / 64.f) + EPS);
        unsigned char* op = (unsigned char*)AO + (size_t)(b * S + rbase + crow(r, hi)) * D + 1024 + head * 64 + r32;
        op[0] = f2fp8(v0 * rinv * gn0); op[32] = f2fp8(v1 * rinv * gn1);
    }
}
__device__ __forceinline__ void attn_phase(const Args& a, LAS unsigned char* lds, int bx, int G, int tid, int wave, int lane) {
    const bf16* P = (const bf16*)(a.ws + WS_P); bf16* AO = (bf16*)(a.ws + WS_AO);
    const float s1 = wave_sum(a.in[8][lane] * a.in[9][lane]), s2 = wave_sum(a.in[10][lane] * a.in[11][lane]);
    const float lam = __expf(s1) - __expf(s2) + 0.2f;
    for (int L = bx; L < 1024; L += G) { const int bh = (L & 7) + 8 * (L >> 8), qb = (L >> 3) & 31; diff_unit(a.ws + WS_Q8, a.ws + WS_K8, a.ws + WS_V8, a.in[12], lam, AO, lds, bh >> 3, bh & 7, qb, tid, wave, lane); }
    for (int L = bx; L < 1024; L += G) { const int bk = (L & 7) + 8 * (L >> 9), hb = (L >> 3) & 63; swa_unit(a.ws + WS_SQ8, a.ws + WS_SK8, a.ws + WS_SV8, a.in[13], a.in[14], AO, lds, bk >> 2, bk & 3, hb, tid, wave, lane); }
}


typedef __bf16 bf16x2_t __attribute__((ext_vector_type(2)));
typedef unsigned v16u __attribute__((ext_vector_type(16)));
__device__ __forceinline__ float dot2bf(unsigned a, unsigned b, float c) { return __builtin_amdgcn_fdot2_f32_bf16(__builtin_bit_cast(bf16x2_t, a), __builtin_bit_cast(bf16x2_t, b), c, false); }
__device__ __forceinline__ float med3(float a, float b, float c) { return __builtin_amdgcn_fmed3f(a, b, c); }
#define TK_INSERT(L, v) do { const float v_ = (v); \
    L[15] = med3(L[14], L[15], v_); L[14] = med3(L[13], L[14], v_); L[13] = med3(L[12], L[13], v_); L[12] = med3(L[11], L[12], v_); \
    L[11] = med3(L[10], L[11], v_); L[10] = med3(L[9], L[10], v_); L[9] = med3(L[8], L[9], v_); L[8] = med3(L[7], L[8], v_); \
    L[7] = med3(L[6], L[7], v_); L[6] = med3(L[5], L[6], v_); L[5] = med3(L[4], L[5], v_); L[4] = med3(L[3], L[4], v_); \
    L[3] = med3(L[2], L[3], v_); L[2] = med3(L[1], L[2], v_); L[1] = med3(L[0], L[1], v_); L[0] = fmaxf(L[0], v_); } while (0)
#define TK_CE(L, a_, b_) do { const float hi_ = fmaxf(L[a_], L[b_]), lo_ = fminf(L[a_], L[b_]); L[a_] = hi_; L[b_] = lo_; } while (0)
#define TK_MERGE(L) do { \
    const float p0_ = xchg32(L[0]), p1_ = xchg32(L[1]), p2_ = xchg32(L[2]), p3_ = xchg32(L[3]), p4_ = xchg32(L[4]), p5_ = xchg32(L[5]), p6_ = xchg32(L[6]), p7_ = xchg32(L[7]); \
    const float p8_ = xchg32(L[8]), p9_ = xchg32(L[9]), p10_ = xchg32(L[10]), p11_ = xchg32(L[11]), p12_ = xchg32(L[12]), p13_ = xchg32(L[13]), p14_ = xchg32(L[14]), p15_ = xchg32(L[15]); \
    L[0] = fmaxf(L[0], p15_); L[1] = fmaxf(L[1], p14_); L[2] = fmaxf(L[2], p13_); L[3] = fmaxf(L[3], p12_); L[4] = fmaxf(L[4], p11_); L[5] = fmaxf(L[5], p10_); L[6] = fmaxf(L[6], p9_); L[7] = fmaxf(L[7], p8_); \
    L[8] = fmaxf(L[8], p7_); L[9] = fmaxf(L[9], p6_); L[10] = fmaxf(L[10], p5_); L[11] = fmaxf(L[11], p4_); L[12] = fmaxf(L[12], p3_); L[13] = fmaxf(L[13], p2_); L[14] = fmaxf(L[14], p1_); L[15] = fmaxf(L[15], p0_); \
    TK_CE(L, 0, 8); TK_CE(L, 1, 9); TK_CE(L, 2, 10); TK_CE(L, 3, 11); TK_CE(L, 4, 12); TK_CE(L, 5, 13); TK_CE(L, 6, 14); TK_CE(L, 7, 15); \
    TK_CE(L, 0, 4); TK_CE(L, 1, 5); TK_CE(L, 2, 6); TK_CE(L, 3, 7); TK_CE(L, 8, 12); TK_CE(L, 9, 13); TK_CE(L, 10, 14); TK_CE(L, 11, 15); \
    TK_CE(L, 0, 2); TK_CE(L, 1, 3); TK_CE(L, 4, 6); TK_CE(L, 5, 7); TK_CE(L, 8, 10); TK_CE(L, 9, 11); TK_CE(L, 12, 14); TK_CE(L, 13, 15); \
    TK_CE(L, 0, 1); TK_CE(L, 2, 3); TK_CE(L, 4, 5); TK_CE(L, 6, 7); TK_CE(L, 8, 9); TK_CE(L, 10, 11); TK_CE(L, 12, 13); TK_CE(L, 14, 15); } while (0)

__device__ __forceinline__ void topk_half(float (&L)[16], const bf16* __restrict__ qp, LAS const unsigned char* skl, int r32, int hi) {
    s16x8 qf[8];
#pragma unroll
    for (int d0 = 0; d0 < 8; ++d0) qf[d0] = *(const s16x8*)(qp + d0 * 16);
#pragma unroll
    for (int j = 0; j < 16; ++j) L[j] = -3.0e38f;
#pragma unroll
    for (int kt = 0; kt < 4; ++kt) {
        f32x16 c;
#pragma unroll
        for (int r = 0; r < 16; ++r) c[r] = 0.f;
#pragma unroll
        for (int d0 = 0; d0 < 8; ++d0) { const int ch = 2 * d0 + hi;
            const s16x8 kf = *(LAS const s16x8*)(skl + ch * 2048 + (((kt * 32 + r32) ^ (ch & 7)) << 4));
            c = __builtin_amdgcn_mfma_f32_32x32x16_bf16(kf, qf[d0], c, 0, 0, 0); }
#pragma unroll
        for (int r = 0; r < 16; ++r) { const unsigned key = (unsigned)(kt * 32 + (r & 3) + 8 * (r >> 2)) | ((unsigned)hi << 2);
            const float pv = __uint_as_float((__float_as_uint(c[r]) & 0xFFFFFF80u) | key); TK_INSERT(L, pv); }
    }
    TK_MERGE(L);
}
__device__ __forceinline__ void topk_item(const bf16* __restrict__ Qp, const bf16* __restrict__ SK, int* __restrict__ IDX, float* __restrict__ G, LAS unsigned char* lds, int h, int tt, int tid, int wave, int lane) {
    const int r32 = lane & 31, hi = lane >> 5;
#pragma unroll
    for (int k = 0; k < 8; ++k) { const int e = tid + 512 * k; const int i = e >> 11, key = (e >> 4) & 127, c = e & 15;
        const u32x4 v = *(const u32x4*)(SK + ((size_t)(h * 2 + i) * 128 + key) * 128 + c * 8);
        *(LAS u32x4*)(lds + i * 32768 + c * 2048 + ((key ^ (c & 7)) << 4)) = v; }
    __syncthreads();
    const int t0 = tt * 256 + wave * 32;
    float s1[16], s2[16];
    topk_half(s1, Qp + (size_t)(t0 + r32) * D + h * 256 + hi * 8, lds, r32, hi);
    topk_half(s2, Qp + (size_t)(t0 + r32) * D + h * 256 + 128 + hi * 8, lds + 32768, r32, hi);
    float T[16];
#pragma unroll
    for (int j = 0; j < 16; ++j) T[j] = -3.0e38f;
#define TK_CAND(aa, bb) do { const float sm_ = s1[aa] + s2[bb]; TK_INSERT(T, __uint_as_float((__float_as_uint(sm_) & 0xFFFFFF00u) | (unsigned)((aa) * 16 + (bb)))); } while (0)
    TK_CAND(0, 0); TK_CAND(0, 1); TK_CAND(0, 2); TK_CAND(0, 3); TK_CAND(0, 4); TK_CAND(0, 5); TK_CAND(0, 6); TK_CAND(0, 7);
    TK_CAND(0, 8); TK_CAND(0, 9); TK_CAND(0, 10); TK_CAND(0, 11); TK_CAND(0, 12); TK_CAND(0, 13); TK_CAND(0, 14); TK_CAND(0, 15);
    TK_CAND(1, 0); TK_CAND(1, 1); TK_CAND(1, 2); TK_CAND(1, 3); TK_CAND(1, 4); TK_CAND(1, 5); TK_CAND(1, 6); TK_CAND(1, 7);
    TK_CAND(2, 0); TK_CAND(2, 1); TK_CAND(2, 2); TK_CAND(2, 3); TK_CAND(2, 4); TK_CAND(3, 0); TK_CAND(3, 1); TK_CAND(3, 2);
    TK_CAND(3, 3); TK_CAND(4, 0); TK_CAND(4, 1); TK_CAND(4, 2); TK_CAND(5, 0); TK_CAND(5, 1); TK_CAND(6, 0); TK_CAND(6, 1);
    TK_CAND(7, 0); TK_CAND(7, 1); TK_CAND(8, 0); TK_CAND(9, 0); TK_CAND(10, 0); TK_CAND(11, 0); TK_CAND(12, 0); TK_CAND(13, 0);
    TK_CAND(14, 0); TK_CAND(15, 0);
#undef TK_CAND
    LAS unsigned* tab = (LAS unsigned*)(lds + 65536) + wave * (32 * 33);
    if (hi == 0) {
#pragma unroll
        for (int j = 0; j < 16; ++j) { tab[r32 * 33 + j] = __float_as_uint(s1[j]) & 0x7Fu; tab[r32 * 33 + 16 + j] = __float_as_uint(s2[j]) & 0x7Fu; }
    }
    float mx = T[0], ev[16], sum = 0.f;
#pragma unroll
    for (int j = 0; j < 16; ++j) { ev[j] = __expf(T[j] - mx); sum += ev[j]; }
    const float inv = 1.f / sum;
    int* ip = IDX + (size_t)(t0 + r32) * 128 + h * 16; float* gp = G + (size_t)(t0 + r32) * 128 + h * 16;
    unsigned oi[16]; float og[16];
#pragma unroll
    for (int j = 0; j < 16; ++j) { const unsigned pc = __float_as_uint(T[j]) & 0xFFu; const unsigned k1 = tab[r32 * 33 + (pc >> 4)], k2 = tab[r32 * 33 + 16 + (pc & 15u)];
        oi[j] = k1 * 128u + k2; og[j] = ev[j] * inv; }
    if (hi == 0) {
        *(u32x4*)ip = (u32x4){oi[0], oi[1], oi[2], oi[3]}; *(u32x4*)(ip + 4) = (u32x4){oi[4], oi[5], oi[6], oi[7]};
        *(f32x4*)gp = (f32x4){og[0], og[1], og[2], og[3]}; *(f32x4*)(gp + 4) = (f32x4){og[4], og[5], og[6], og[7]};
    } else {
        *(u32x4*)(ip + 8) = (u32x4){oi[8], oi[9], oi[10], oi[11]}; *(u32x4*)(ip + 12) = (u32x4){oi[12], oi[13], oi[14], oi[15]};
        *(f32x4*)(gp + 8) = (f32x4){og[8], og[9], og[10], og[11]}; *(f32x4*)(gp + 12) = (f32x4){og[12], og[13], og[14], og[15]};
    }
    __syncthreads();
}
__device__ __forceinline__ void topk_phase(const Args& a, LAS unsigned char* lds, int bx, int G, int tid, int wave, int lane) {
    const bf16* Qp = (const bf16*)(a.ws + WS_QP); const bf16* SK = (const bf16*)(a.ws + WS_SK);
    int* IDX = (int*)(a.ws + WS_IDX); float* Gt = (float*)(a.ws + WS_G);
    pg8::StaticOrder S; S.init(M, D, G, bx);
    pg8::Unit u;
    for (int i = 0; S.next(i, u); ++i) topk_item(Qp, SK, IDX, Gt, lds, u.pn, u.pm, tid, wave, lane);
}

__device__ __forceinline__ float gelu_tanh_f(float x) { const float u = 0.7978845608028654f * (x + 0.044715f * x * x * x); const float e = __expf(2.f * u); return 0.5f * x * (1.f + (1.f - 2.f / (e + 1.f))); }
#define P8_LOAD(buf, scl, TAB, SCT, e0_) do { _Pragma("unroll") for (int q_ = 0; q_ < 8; ++q_) { const int e_ = (e0_) + q_; const int idx_ = __builtin_amdgcn_readlane(e_ < 64 ? id0 : id1, e_ & 63); \
        const unsigned char* p_ = (TAB) + (size_t)idx_ * 2048; buf##A[q_] = *(const u32x4*)(p_ + lane * 16); buf##B[q_] = *(const u32x2*)(p_ + 1024 + lane * 8); scl[q_] = __uint_as_float((unsigned)(SCT)[idx_] << 16); } } while (0)
#define P8_DEC(buf, q_) __builtin_amdgcn_cvt_scalef32_pk32_f32_fp6((v6u){buf##A[q_].x, buf##A[q_].y, buf##A[q_].z, buf##A[q_].w, buf##B[q_].x, buf##B[q_].y}, 1.0f)
#define P8_UGROUP(buf, scl, e0_) do { float d_[8]; \
        _Pragma("unroll") for (int q_ = 0; q_ < 8; ++q_) { const v16u r_ = __builtin_bit_cast(v16u, __builtin_amdgcn_cvt_scalef32_pk32_bf16_fp6((v6u){buf##A[q_].x, buf##A[q_].y, buf##A[q_].z, buf##A[q_].w, buf##B[q_].x, buf##B[q_].y}, 1.0f)); float s0_ = 0.f, s1_ = 0.f; \
            _Pragma("unroll") for (int i_ = 0; i_ < 16; i_ += 2) { s0_ = dot2bf(r_[i_], hvp[i_], s0_); s1_ = dot2bf(r_[i_ + 1], hvp[i_ + 1], s1_); } d_[q_] = s0_ + s1_; __builtin_amdgcn_sched_barrier(0); } \
        float d4_[4], d2_[2]; \
        _Pragma("unroll") for (int q_ = 0; q_ < 4; ++q_) { const float keep_ = b5 ? d_[q_ + 4] : d_[q_], send_ = b5 ? d_[q_] : d_[q_ + 4]; d4_[q_] = keep_ + xchg32(send_); } \
        _Pragma("unroll") for (int q_ = 0; q_ < 2; ++q_) { const float keep_ = b4 ? d4_[q_ + 2] : d4_[q_], send_ = b4 ? d4_[q_] : d4_[q_ + 2]; d2_[q_] = keep_ + __shfl_xor(send_, 16); } \
        float d1_ = (b3 ? d2_[1] : d2_[0]) + __shfl_xor(b3 ? d2_[0] : d2_[1], 8); \
        d1_ += __shfl_xor(d1_, 4); d1_ += __shfl_xor(d1_, 2); d1_ += __shfl_xor(d1_, 1); \
        const float sa_ = b3 ? scl[1] : scl[0], sb_ = b3 ? scl[3] : scl[2], sc_ = b3 ? scl[5] : scl[4], sd_ = b3 ? scl[7] : scl[6]; \
        const float sl_ = b5 ? (b4 ? sd_ : sc_) : (b4 ? sb_ : sa_); \
        const float act_ = gelu_tanh_f(d1_ * sl_); \
        const float rc_ = __shfl(act_, ((lane - (e0_)) & 7) * 8); \
        if ((e0_) < 64) { if ((unsigned)(lane - (e0_)) < 8u) w0 = g0 * rc_; } else { if ((unsigned)(lane - ((e0_) - 64)) < 8u) w1 = g1 * rc_; } } while (0)
typedef float f32x2 __attribute__((ext_vector_type(2)));
#define P8_VLOAD(buf, scl, e0_) do { _Pragma("unroll") for (int q_ = 0; q_ < 8; ++q_) { const int e_ = (e0_) + q_; const int idx_ = __builtin_amdgcn_readlane(e_ < 64 ? id0 : id1, e_ & 63); \
        buf[q_] = *(const u32x4*)(V4 + (size_t)idx_ * 1024 + lane * 16); scl[q_] = __uint_as_float((unsigned)SVl[idx_] << 16); } } while (0)
#define P8_VGROUP(buf, scl, e0_) do { _Pragma("unroll") for (int q_ = 0; q_ < 8; ++q_) { const int e_ = (e0_) + q_; \
        const float wq_ = __int_as_float(__builtin_amdgcn_readlane(__float_as_int(e_ < 64 ? w0 : w1), e_ & 63)) * scl[q_]; \
        acc2[0] += __builtin_amdgcn_cvt_scalef32_pk_f32_fp4(buf[q_][0], 1.0f, 0) * wq_; acc2[1] += __builtin_amdgcn_cvt_scalef32_pk_f32_fp4(buf[q_][0], 1.0f, 1) * wq_; \
        acc2[2] += __builtin_amdgcn_cvt_scalef32_pk_f32_fp4(buf[q_][0], 1.0f, 2) * wq_; acc2[3] += __builtin_amdgcn_cvt_scalef32_pk_f32_fp4(buf[q_][0], 1.0f, 3) * wq_; \
        acc2[4] += __builtin_amdgcn_cvt_scalef32_pk_f32_fp4(buf[q_][1], 1.0f, 0) * wq_; acc2[5] += __builtin_amdgcn_cvt_scalef32_pk_f32_fp4(buf[q_][1], 1.0f, 1) * wq_; \
        acc2[6] += __builtin_amdgcn_cvt_scalef32_pk_f32_fp4(buf[q_][1], 1.0f, 2) * wq_; acc2[7] += __builtin_amdgcn_cvt_scalef32_pk_f32_fp4(buf[q_][1], 1.0f, 3) * wq_; \
        acc2[8] += __builtin_amdgcn_cvt_scalef32_pk_f32_fp4(buf[q_][2], 1.0f, 0) * wq_; acc2[9] += __builtin_amdgcn_cvt_scalef32_pk_f32_fp4(buf[q_][2], 1.0f, 1) * wq_; \
        acc2[10] += __builtin_amdgcn_cvt_scalef32_pk_f32_fp4(buf[q_][2], 1.0f, 2) * wq_; acc2[11] += __builtin_amdgcn_cvt_scalef32_pk_f32_fp4(buf[q_][2], 1.0f, 3) * wq_; \
        acc2[12] += __builtin_amdgcn_cvt_scalef32_pk_f32_fp4(buf[q_][3], 1.0f, 0) * wq_; acc2[13] += __builtin_amdgcn_cvt_scalef32_pk_f32_fp4(buf[q_][3], 1.0f, 1) * wq_; \
        acc2[14] += __builtin_amdgcn_cvt_scalef32_pk_f32_fp4(buf[q_][3], 1.0f, 2) * wq_; acc2[15] += __builtin_amdgcn_cvt_scalef32_pk_f32_fp4(buf[q_][3], 1.0f, 3) * wq_; \
        __builtin_amdgcn_sched_barrier(0); } } while (0)
__device__ __forceinline__ void peer_phase(const Args& a, LAS unsigned char* lds, int gw, int NGW, int tid, int lane) {
    const float* SU = (const float*)(a.ws + WS_U + 32 * MiB); const float* SV = (const float*)(a.ws + WS_V + 32 * MiB);
    LAS float* AMv = (LAS float*)lds; LAS float* SHv = AMv + NB * D;
#pragma unroll
    for (int i = 0; i < 8; ++i) { const int idx = (i * NTHREADS + tid) * 4; *(LAS f32x4*)(AMv + idx) = *(const f32x4*)((const float*)(a.ws + WS_AMSH) + idx); }
    LAS float* FNl = SHv + NB * D; LAS unsigned short* G2l = (LAS unsigned short*)(FNl + D); LAS unsigned short* SVl = G2l + NB * D; LAS unsigned short* SUl = SVl + 16384;
    *(LAS f32x4*)(FNl + tid * 4) = *(const f32x4*)(a.in[21] + tid * 4);
#pragma unroll
    for (int i = 0; i < 4; ++i) { const int idx = (i * NTHREADS + tid) * 4; const f32x4 g4 = modf4((const long long*)(a.ws + WS_MOD) + (size_t)(idx >> 11) * MODW + 5 * D + (idx & (D - 1)));
        *(LAS u32x2*)(G2l + idx) = (u32x2){pk2(g4[0], g4[1]), pk2(g4[2], g4[3])}; }
#pragma unroll
    for (int i = 0; i < 8; ++i) { const int idx = (i * NTHREADS + tid) * 4; const f32x4 s4 = *(const f32x4*)(SV + idx), u4 = *(const f32x4*)(SU + idx);
        *(LAS u32x2*)(SVl + idx) = (u32x2){pk2(s4[0], s4[1]), pk2(s4[2], s4[3])}; *(LAS u32x2*)(SUl + idx) = (u32x2){pk2(u4[0], u4[1]), pk2(u4[2], u4[3])}; }
    __syncthreads();
    const unsigned char* U6 = a.ws + WS_U; const unsigned char* V4 = a.ws + WS_V;
    const int* IDX = (const int*)(a.ws + WS_IDX); const float* Gt = (const float*)(a.ws + WS_G);
    const long long* MOD = (const long long*)(a.ws + WS_MOD); const float* fn = a.in[21]; float* xio = a.out; const bf16* X1 = (const bf16*)(a.ws + WS_X1);
    for (int t = gw; t < M; t += NGW) {
        asm volatile("" : "+v"(lane));
        const bool b5 = (lane & 32) != 0, b4 = (lane & 16) != 0, b3 = (lane & 8) != 0;
        const int b = t >> 12;
        const int id0 = IDX[(size_t)t * 128 + lane], id1 = IDX[(size_t)t * 128 + 64 + lane];
        const float g0 = Gt[(size_t)t * 128 + lane], g1 = Gt[(size_t)t * 128 + 64 + lane];
        u32x4 baA[8], bbA[8]; u32x2 baB[8], bbB[8]; float sa[8], sb[8]; u32x4 va[8], vb[8];
        P8_LOAD(ba, sa, U6, SUl, 0);
        unsigned hvp[16];
        {
            f32x4 xv[8]; float ssx = 0.f;
#pragma unroll
            for (int j = 0; j < 8; ++j) { const u32x2 w = *(const u32x2*)(X1 + (size_t)t * D + 256 * j + lane * 4);
                xv[j] = (f32x4){__uint_as_float(w.x << 16), __uint_as_float(w.x & 0xffff0000u), __uint_as_float(w.y << 16), __uint_as_float(w.y & 0xffff0000u)};
                ssx += (xv[j][0] * xv[j][0] + xv[j][1] * xv[j][1]) + (xv[j][2] * xv[j][2] + xv[j][3] * xv[j][3]); }
            const float rs = rsqrtf(wave_sum(ssx) * (1.f / D) + EPS);
#pragma unroll
            for (int j = 0; j < 8; ++j) { const f32x4 am = *(LAS const f32x4*)(AMv + b * D + 256 * j + lane * 4), sh = *(LAS const f32x4*)(SHv + b * D + 256 * j + lane * 4);
                const f32x4 y = xv[j] * rs * am + sh; hvp[2 * j] = pk2(y[0], y[1]); hvp[2 * j + 1] = pk2(y[2], y[3]); }
        }
        float w0 = 0.f, w1 = 0.f;
#pragma unroll 1
        for (int e0 = 0; e0 < 128; e0 += 16) {
            P8_LOAD(bb, sb, U6, SUl, e0 + 8);
            P8_UGROUP(ba, sa, e0);
            if (e0 + 16 < 128) P8_LOAD(ba, sa, U6, SUl, e0 + 16); else P8_VLOAD(va, sa, 0);
            P8_UGROUP(bb, sb, e0 + 8);
        }
        f32x2 acc2[16];
#pragma unroll
        for (int j = 0; j < 16; ++j) acc2[j] = (f32x2){0.f, 0.f};
#pragma unroll 1
        for (int e0 = 0; e0 < 128; e0 += 16) {
            P8_VLOAD(vb, sb, e0 + 8);
            P8_VGROUP(va, sa, e0);
            if (e0 + 16 < 128) P8_VLOAD(va, sa, e0 + 16);
            P8_VGROUP(vb, sb, e0 + 8);
        }
        float acc[32];
#pragma unroll
        for (int j = 0; j < 16; ++j) { acc[2 * j] = acc2[j].x; acc[2 * j + 1] = acc2[j].y; }
        float ss = 0.f;
#pragma unroll
        for (int j = 0; j < 8; ++j) { const int col = 256 * j + lane * 4; const u32x2 xw = *(const u32x2*)(X1 + (size_t)t * D + col);
            const f32x4 x0 = {__uint_as_float(xw.x << 16), __uint_as_float(xw.x & 0xffff0000u), __uint_as_float(xw.y << 16), __uint_as_float(xw.y & 0xffff0000u)};
            const u32x2 gw_ = *(LAS const u32x2*)(G2l + b * D + col); const f32x4 ga = {__uint_as_float(gw_.x << 16), __uint_as_float(gw_.x & 0xffff0000u), __uint_as_float(gw_.y << 16), __uint_as_float(gw_.y & 0xffff0000u)};
#pragma unroll
            for (int k = 0; k < 4; ++k) { const float y = x0[k] + ga[k] * acc[4 * j + k]; acc[4 * j + k] = y; ss += y * y; } }
        ss = wave_sum(ss);
        const float rstd = rsqrtf(ss * (1.f / D) + EPS);
#pragma unroll
        for (int j = 0; j < 8; ++j) { const int col = 256 * j + lane * 4; const f32x4 f0 = *(LAS const f32x4*)(FNl + col);
            f32x4 o;
#pragma unroll
            for (int k = 0; k < 4; ++k) o[k] = acc[4 * j + k] * rstd * f0[k];
            *(f32x4*)(xio + (size_t)t * D + col) = o; }
    }
}


__global__ void __launch_bounds__(NTHREADS, 2) mega(Args a) {
    extern __shared__ __attribute__((aligned(16))) unsigned char lds_raw[];
    LAS unsigned char* lds = (LAS unsigned char*)lds_raw;
    const int tid = threadIdx.x, lane = tid & 63, wave = __builtin_amdgcn_readfirstlane(tid >> 6);
    const int G = gridDim.x, bx = blockIdx.x;
    const int vcu = (G % 8 == 0) ? (bx % 8) * (G / 8) + bx / 8 : bx;
    const int gw = vcu * NWAVES + wave, NGW = G * NWAVES;
    unsigned char* ws = a.ws;
    const long long* MOD = (const long long*)(ws + WS_MOD);
    bf16* H = (bf16*)(ws + WS_H); bf16* P = (bf16*)(ws + WS_P); bf16* AO = (bf16*)(ws + WS_AO); bf16* Qp = (bf16*)(ws + WS_QP);
    const int lo = a.ph_lo, hi = a.ph_hi;
    cooperative_groups::grid_group grid = cooperative_groups::this_grid();
#define IN(k) (lo <= (k) && (k) < hi)
#define SEAM(k) do { if (IN(k) && IN((k) + 1)) xcd_barrier(bar); } while (0)
    if (a.ph_lo < 0) grid.sync();
    volatile LAS unsigned* MISC = (volatile LAS unsigned*)(lds + LDS_BYTES - 256);
    if (tid < 32) MISC[tid] = 0u;
    __syncthreads();
    const XcdBarrier bar = xcd_barrier_post((unsigned*)(ws + WS_CTL), MISC + 8);
    if (IN(0)) { p0_prep(a, lds, gw, NGW, wave, lane); }
    SEAM(0);
    if (IN(1)) {
        norm_rows(a.in[0], M, a.in[6], MOD, 0, D, -1, (unsigned char*)H, gw, NGW, lane);
        norm_rows(a.in[2], MC, a.in[6], MOD, 0, D, 4, (unsigned char*)H + (size_t)M * D, gw, NGW, lane);
        p1_fold(a, lds, gw, NGW, tid, lane);
    }
    SEAM(1);
    if (IN(2)) {
        pg8::Gemm g{H, (const bf16*)(ws + WS_WIN), MT, PW, D / 2}; Order1 S{G, bx};
        EpiRope E{P, (const float*)(ws + WS_ROPE), ws};
        pg8::gemm_phase<EpiRope, Order1, true, true, true, 127, 122>(lds, g, S, E);
        if (a.tab_r0 < 2 * 16384 && bx >= 1192 % G) p0_tables<4>(a, a.tab_r0, 2 * 16384, (bx - 1192 % G) * NWAVES + wave, (G - 1192 % G) * NWAVES, lane);
    }
    SEAM(2);
    if (IN(3)) { attn_phase(a, lds, bx, G, tid, wave, lane); }
    SEAM(3);
    if (IN(4)) {
        pg8::Gemm g{AO, (const bf16*)(ws + WS_WOUT), M, D, D / 2}; pg8::StaticOrder S; S.init(M, D, G, bx);
        EpiRes E{a.in[0], MOD, (bf16*)(ws + WS_X1), (unsigned long long*)(ws + WS_ROWSS)};
        pg8::gemm_phase<EpiRes, pg8::StaticOrder, true, true, true, 127, 122>(lds, g, S, E);
    }
    SEAM(4);
    if (IN(6)) {
        pg8::Gemm g{(const bf16*)(ws + WS_X1), (const bf16*)(ws + WS_WQB), M, D, D}; Order6 S; S.S.init(M, D, G, bx);
        EpiQ2 E{Qp, (const unsigned long long*)(ws + WS_ROWSS), (const float*)(ws + WS_QBIAS)};
        pg8::gemm_phase<EpiQ2, Order6, true, true>(lds, g, S, E);
    }
    if (IN(6) && IN(7)) {
        asm volatile("s_waitcnt vmcnt(0)" ::: "memory");
        __builtin_amdgcn_fence(__ATOMIC_ACQUIRE, "agent");
        __syncthreads();
    }
    if (IN(7)) { topk_phase(a, lds, bx, G, tid, wave, lane); }
    SEAM(7);
    if (IN(8)) { peer_phase(a, lds, gw, NGW, tid, lane); }
#undef IN
#undef SEAM
}

extern "C" void kernel_launch(void* const* d_in, const int* in_sizes, int n_in, void* d_out, int out_size, void* d_ws, size_t ws_size, hipStream_t stream) {
    static int grid = 0;
    if (grid == 0) {
        int dev = 0, cus = 0, per_cu = 0;
        (void)hipGetDevice(&dev); (void)hipDeviceGetAttribute(&cus, hipDeviceAttributeMultiprocessorCount, dev);
        (void)hipFuncSetAttribute((const void*)mega, hipFuncAttributeMaxDynamicSharedMemorySize, LDS_BYTES);
        (void)hipOccupancyMaxActiveBlocksPerMultiprocessor(&per_cu, (const void*)mega, NTHREADS, LDS_BYTES);
        if (per_cu < 1) per_cu = 1;
        grid = (cus > 0 ? cus : 256) * per_cu;
    }
    if (ws_size < WS_END) { fprintf(stderr, "kernel_launch: workspace too small (%zu < %zu)\n", ws_size, (size_t)WS_END); return; }
    unsigned char* ws = (unsigned char*)d_ws;
    (void)hipMemsetAsync(ws + WS_CTL, 0, WS_MOD + 5 * MODW * 8, stream);
    Args a{};
    for (int i = 0; i < 22; ++i) a.in[i] = (const float*)d_in[i];
    a.out = (float*)d_out; a.ws = ws; a.ph_lo = 0; a.ph_hi = 9;
    a.tab_r0 = (1192 % grid) ? TAB_R0 : 2 * 16384;

    void* args[] = {&a};
    hipError_t e = hipLaunchCooperativeKernel((const void*)mega, dim3(grid), dim3(NTHREADS), args, LDS_BYTES, stream);
    if (e != hipSuccess) fprintf(stderr, "cooperative launch failed: %s (grid %d)\n", hipGetErrorString(e), grid);
}
```

```cpp
#include <hip/hip_runtime.h>
#include <hip/hip_cooperative_groups.h>
#include <stdint.h>
#include <cstdio>

typedef unsigned short bf16;
constexpr int D = 2048, NB = 4, S = 4096, CL = 256, M = NB * S, MC = NB * CL, MT = M + MC;
constexpr int PW = 4608, MODW = 6 * D;
constexpr float EPS = 1e-6f;

__device__ __forceinline__ float bf2f(bf16 v) { return __uint_as_float(((unsigned)v) << 16); }
__device__ __forceinline__ bf16 f2bf(float f) { unsigned u = __float_as_uint(f); return (bf16)((u + 0x7fffu + ((u >> 16) & 1u)) >> 16); }
template <int CTRL> __device__ __forceinline__ float hd_dpp(float v) { return __int_as_float(__builtin_amdgcn_update_dpp(0, __float_as_int(v), CTRL, 0xf, 0xf, true)); }
__device__ __forceinline__ float wave_sum(float v) {
    v += hd_dpp<0xB1>(v); v += hd_dpp<0x4E>(v); v += hd_dpp<0x141>(v); v += hd_dpp<0x140>(v);
    { auto r_ = __builtin_amdgcn_permlane16_swap(__float_as_uint(v), __float_as_uint(v), false, false); v = __uint_as_float(r_[0]) + __uint_as_float(r_[1]); }
    { auto r_ = __builtin_amdgcn_permlane32_swap(__float_as_uint(v), __float_as_uint(v), false, false); v = __uint_as_float(r_[0]) + __uint_as_float(r_[1]); }
    return v;
}
__device__ __forceinline__ float wave_max(float v) {
    v = fmaxf(v, hd_dpp<0xB1>(v)); v = fmaxf(v, hd_dpp<0x4E>(v)); v = fmaxf(v, hd_dpp<0x141>(v)); v = fmaxf(v, hd_dpp<0x140>(v));
    { auto r_ = __builtin_amdgcn_permlane16_swap(__float_as_uint(v), __float_as_uint(v), false, false); v = fmaxf(__uint_as_float(r_[0]), __uint_as_float(r_[1])); }
    { auto r_ = __builtin_amdgcn_permlane32_swap(__float_as_uint(v), __float_as_uint(v), false, false); v = fmaxf(__uint_as_float(r_[0]), __uint_as_float(r_[1])); }
    return v;
}

constexpr size_t MiB = 1u << 20;
constexpr size_t WS_CTL = 0;
constexpr size_t WS_MOD = 1 * MiB;
constexpr size_t WS_MODF = 512 * 1024;
constexpr size_t WS_ROPE = WS_MOD + 512 * 1024;
constexpr size_t WS_AMSH = WS_ROPE + 64 * 1024;
constexpr size_t WS_QBIAS = WS_ROPE + 128 * 1024;
constexpr size_t WS_ROWSS = 256 * 1024;
constexpr size_t WS_SK = 2 * MiB;
constexpr size_t WS_WIN = 3 * MiB;
constexpr size_t WS_WOUT = 21 * MiB;
constexpr size_t WS_WQ = 29 * MiB;
constexpr size_t WS_U = 37 * MiB;
constexpr size_t WS_V = 101 * MiB;
constexpr size_t WS_H = 165 * MiB;
constexpr size_t WS_P = 233 * MiB;
constexpr size_t WS_X1 = WS_P;
constexpr size_t WS_QP = 386 * MiB;
constexpr size_t WS_IDX = 450 * MiB;
constexpr size_t WS_G = 458 * MiB;
constexpr size_t WS_AO = WS_QP;
constexpr size_t WS_WQB = 466 * MiB;
constexpr size_t WS_V8 = 498 * MiB;
constexpr size_t WS_Q8 = 516 * MiB;
constexpr size_t WS_K8 = 534 * MiB;
constexpr size_t WS_SQ8 = WS_P + 64 * MiB;
constexpr size_t WS_SK8 = WS_P + 80 * MiB;
constexpr size_t WS_SV8 = WS_P + 88 * MiB;
constexpr size_t WS_END = 552 * MiB;


namespace pg8 {
#define PG8_LAS __attribute__((address_space(3)))
typedef unsigned short bf16_t;
typedef short bf16x8 __attribute__((ext_vector_type(8)));
typedef float f32x4 __attribute__((ext_vector_type(4)));
typedef unsigned u32x4 __attribute__((ext_vector_type(4)));
constexpr int BM = 256, BK = 64, HALF = 128, HTB = HALF * BK * 2  , STAGE_BYTES = 8 * HTB, NXCD = 8, WGM = 8;

__host__ __device__ __forceinline__ int lds_byte(int r, int c) { const int st = (r >> 4) * 2 + (c >> 5), rr = r & 15, cc = c & 31, ob = rr * 64 + cc * 2; return st * 1024 + (ob ^ (((ob >> 9) & 1) << 5)); }
__host__ __device__ __forceinline__ void stage_rc(int b, int& R, int& C) { const int st = b / 1024, sb = b % 1024, swz = sb ^ (((sb >> 9) & 1) << 5); R = (st >> 1) * 16 + swz / 64; C = (st & 1) * 32 + (swz % 64) / 2; }
__host__ __device__ __forceinline__ int perm32(int rho) { const int n = rho >> 4, i = rho & 15; return 8 * (i >> 2) + 4 * n + (i & 3); }

struct Unit { int pm, pn; };
struct Gemm { const bf16_t* A; const bf16_t* Bt; int M, N, K; };

struct StaticOrder {
    int nM, nN, nwg, G, c;
    __host__ __device__ void init(int M, int N, int G_, int c_) { nM = M / BM; nN = N / BM; nwg = nM * nN; G = G_; c = c_; }
    __host__ __device__ bool next(int i, Unit& u) const {
        const long L = (long)i * G + c; if (L >= nwg) return false;
        int wgid = (int)L; { const int q = nwg / NXCD, r = nwg % NXCD, xcd = wgid % NXCD, off = wgid / NXCD; wgid = (xcd < r ? xcd * (q + 1) : r * (q + 1) + (xcd - r) * q) + off; }
        const int nig = WGM * nN, gid = wgid / nig, fm = gid * WGM, gsz = (nM - fm) < WGM ? (nM - fm) : WGM;
        u.pm = fm + ((wgid % nig) % gsz); u.pn = (wgid % nig) / gsz; return true;
    }
    __device__ __forceinline__ void a_ready(const Unit&) const {}
    __device__ __forceinline__ void done(const Unit&) const {}
};
__device__ __forceinline__ unsigned cvt_pk_bf16(float lo, float hi) { unsigned r; asm volatile("v_cvt_pk_bf16_f32 %0, %1, %2" : "=v"(r) : "v"(lo), "v"(hi)); return r; }

template <class Epi, class Sched, bool ALIGN_EPI = false, bool SP2 = false, bool FP8 = false, int SCA = 127, int SCB = 127>
__device__ __forceinline__ void gemm_phase(PG8_LAS unsigned char* lds, const Gemm g, const Sched& S, const Epi& E) {
    const int tid = threadIdx.x, wid = __builtin_amdgcn_readfirstlane(tid >> 6), lane = tid & 63, wr = wid >> 2, wc = wid & 3, fr = lane & 15, fq = lane >> 4;
    const int K = g.K, nt = K / BK;
    unsigned voffA[2], voffB[2];
#pragma unroll
    for (int i = 0; i < 2; ++i) { int R, C; stage_rc(tid * 16 + i * 8192, R, C); const int Rb = Epi::PERM ? ((R & ~31) + perm32(R & 31)) : R;
        voffA[i] = (unsigned)(R * K + C) * 2u; voffB[i] = (unsigned)(Rb * K + C) * 2u; }
    const size_t kstep = (size_t)(BK * 2);
    const size_t hstep = (size_t)HALF * K * 2;
    const size_t tstep = 2 * hstep;
    const unsigned ldsw = (unsigned)wid * 1024u;
    const int aoff = lds_byte(wr * 64 + fr, fq * 8), boff = lds_byte(wc * 32 + fr, fq * 8);
    const int c81 = fq * 16 + (fq & 1) * 8, c82 = fq * 16 + ((fq & 1) ? 0 : 8);
    const int aoff1 = lds_byte(wr * 64 + fr, c81), aoff2 = lds_byte(wr * 64 + fr, c82), boff1 = lds_byte(wc * 32 + fr, c81), boff2 = lds_byte(wc * 32 + fr, c82);
#define PG8_SA(b, h) (((b) * 2 + (h)) * HTB)
#define PG8_SB(b, h) ((4 + (b) * 2 + (h)) * HTB)
#define PG8_STAGE(bufoff, gbase, voff) do { _Pragma("unroll") for (int _i = 0; _i < 2; ++_i) \
        __builtin_amdgcn_global_load_lds((const unsigned*)((const char*)(gbase) + (voff)[_i]), (PG8_LAS unsigned*)(lds + (bufoff) + ldsw + _i * 8192), 16, 0, 0); } while (0)
#define PG8_LDA(dst, b, h) do { if constexpr (FP8) { _Pragma("unroll") for (int m = 0; m < 4; ++m) { dst##L[m] = *(const PG8_LAS u32x4*)(lds + PG8_SA(b, h) + aoff1 + m * 2048); dst##H[m] = *(const PG8_LAS u32x4*)(lds + PG8_SA(b, h) + aoff2 + m * 2048); } } \
        else { _Pragma("unroll") for (int m = 0; m < 4; ++m) _Pragma("unroll") for (int k = 0; k < 2; ++k) dst[m][k] = *(const PG8_LAS bf16x8*)(lds + PG8_SA(b, h) + aoff + m * 2048 + k * 1024); } } while (0)
#define PG8_LDB(dst, b, h) do { if constexpr (FP8) { _Pragma("unroll") for (int n = 0; n < 2; ++n) { dst##L[n] = *(const PG8_LAS u32x4*)(lds + PG8_SB(b, h) + boff1 + n * 2048); dst##H[n] = *(const PG8_LAS u32x4*)(lds + PG8_SB(b, h) + boff2 + n * 2048); } } \
        else { _Pragma("unroll") for (int n = 0; n < 2; ++n) _Pragma("unroll") for (int k = 0; k < 2; ++k) dst[n][k] = *(const PG8_LAS bf16x8*)(lds + PG8_SB(b, h) + boff + n * 2048 + k * 1024); } } while (0)
#define PG8_CAT8(lo_, hi_) __builtin_bit_cast(i32x8, __builtin_shufflevector(lo_, hi_, 0, 1, 2, 3, 4, 5, 6, 7))
#define PG8_MMA(ai, bj, At, Bt) do { __builtin_amdgcn_s_setprio(1); if constexpr (FP8) { _Pragma("unroll") for (int m = 0; m < 4; ++m) _Pragma("unroll") for (int n = 0; n < 2; ++n) \
            asm volatile("v_mfma_scale_f32_16x16x128_f8f6f4 %0, %1, %2, %0, %3, %4 op_sel_hi:[0,0,0]" : "+v"(acc[ai][bj][m][n]) : "v"(PG8_CAT8(Bt##L[n], Bt##H[n])), "v"(PG8_CAT8(At##L[m], At##H[m])), "v"(scb_), "v"(sca_)); } \
        else { _Pragma("unroll") for (int m = 0; m < 4; ++m) _Pragma("unroll") for (int n = 0; n < 2; ++n) _Pragma("unroll") for (int k = 0; k < 2; ++k) \
            acc[ai][bj][m][n] = __builtin_amdgcn_mfma_f32_16x16x32_bf16(Bt[n][k], At[m][k], acc[ai][bj][m][n], 0, 0, 0); } __builtin_amdgcn_s_setprio(0); } while (0)
#define PG8_WAIT_V(n) asm volatile("s_waitcnt vmcnt(" #n ")" ::: "memory")
#define PG8_WAIT_L(n) asm volatile("s_waitcnt lgkmcnt(" #n ")" ::: "memory")
#define PG8_BAR __builtin_amdgcn_s_barrier()
#define PG8_SCHED __builtin_amdgcn_sched_barrier(0)
    Unit cur, nxt; int ui = 0;
    if (!S.next(0, cur)) return;
    f32x4 acc[2][2][4][2];
#pragma unroll
    for (int a = 0; a < 2; ++a)
#pragma unroll
        for (int b = 0; b < 2; ++b)
#pragma unroll
            for (int m = 0; m < 4; ++m)
#pragma unroll
                for (int n = 0; n < 2; ++n) acc[a][b][m][n] = (f32x4){0.f, 0.f, 0.f, 0.f};
    bf16x8 At[4][2], B0[2][2], B1[2][2];
    typedef int i32x8 __attribute__((ext_vector_type(8)));
    u32x4 AtL[4], AtH[4], B0L[2], B0H[2], B1L[2], B1H[2];
    const int scb_ = SCB * 0x01010101, sca_ = SCA * 0x01010101;
    const char* cA = (const char*)g.A + (size_t)cur.pm * tstep; const char* cB = (const char*)g.Bt + (size_t)cur.pn * tstep;
    S.a_ready(cur);
    if constexpr (SP2) {
        PG8_STAGE(PG8_SB(0, 0), cB, voffB); PG8_STAGE(PG8_SB(0, 1), cB + hstep, voffB); PG8_STAGE(PG8_SA(0, 0), cA, voffA); PG8_STAGE(PG8_SA(0, 1), cA + hstep, voffA);
        if (wr == 1) PG8_BAR;
        PG8_WAIT_V(2); PG8_BAR;
        PG8_STAGE(PG8_SB(1, 0), cB + kstep, voffB); PG8_STAGE(PG8_SA(1, 0), cA + kstep, voffA); PG8_STAGE(PG8_SB(1, 1), cB + hstep + kstep, voffB);
        PG8_WAIT_V(6); PG8_BAR;
    } else {
        PG8_STAGE(PG8_SB(0, 0), cB, voffB); PG8_STAGE(PG8_SA(0, 0), cA, voffA); PG8_STAGE(PG8_SB(0, 1), cB + hstep, voffB); PG8_STAGE(PG8_SA(0, 1), cA + hstep, voffA);
        if (wr == 1) PG8_BAR;
        PG8_WAIT_V(4); PG8_BAR;
        PG8_STAGE(PG8_SB(1, 0), cB + kstep, voffB); PG8_STAGE(PG8_SA(1, 0), cA + kstep, voffA); PG8_STAGE(PG8_SB(1, 1), cB + hstep + kstep, voffB);
        PG8_WAIT_V(6); PG8_BAR;
    }
    for (;;) {
        const bool has_next = S.next(ui + 1, nxt);
        const char* nA = has_next ? (const char*)g.A + (size_t)nxt.pm * tstep : cA; const char* nB = has_next ? (const char*)g.Bt + (size_t)nxt.pn * tstep : cB;
        for (int t = 0; t < nt; t += 2) {
            const bool last = (t == nt - 2);
            const char* a1 = cA + (size_t)(t + 1) * kstep;
            const char* a2 = last ? nA : cA + (size_t)(t + 2) * kstep; const char* b2 = last ? nB : cB + (size_t)(t + 2) * kstep;
            const char* a3 = a2 + kstep; const char* b3 = b2 + kstep;
            if (last && has_next) S.a_ready(nxt);
            if constexpr (SP2) {
            PG8_LDB(B0, 0, 0); PG8_LDB(B1, 0, 1); PG8_SCHED; PG8_LDA(At, 0, 0); PG8_STAGE(PG8_SA(1, 1), a1 + hstep, voffA);
            PG8_WAIT_V(8); PG8_WAIT_L(0); PG8_BAR; PG8_MMA(0, 0, At, B0); PG8_MMA(0, 1, At, B1); PG8_BAR; PG8_SCHED;
            PG8_LDA(At, 0, 1); PG8_STAGE(PG8_SB(0, 0), b2, voffB); PG8_STAGE(PG8_SB(0, 1), b2 + hstep, voffB); PG8_STAGE(PG8_SA(0, 0), a2, voffA);
            PG8_WAIT_V(8); PG8_WAIT_L(0); PG8_BAR; PG8_MMA(1, 0, At, B0); PG8_MMA(1, 1, At, B1); PG8_BAR; PG8_SCHED;
            PG8_LDB(B0, 1, 0); PG8_LDB(B1, 1, 1); PG8_SCHED; PG8_LDA(At, 1, 0); PG8_STAGE(PG8_SA(0, 1), a2 + hstep, voffA);
            PG8_WAIT_V(8); PG8_WAIT_L(0); PG8_BAR; PG8_MMA(0, 0, At, B0); PG8_MMA(0, 1, At, B1); PG8_BAR; PG8_SCHED;
            PG8_LDA(At, 1, 1); PG8_STAGE(PG8_SB(1, 0), b3, voffB); PG8_STAGE(PG8_SB(1, 1), b3 + hstep, voffB); PG8_STAGE(PG8_SA(1, 0), a3, voffA);
            PG8_WAIT_V(8); PG8_WAIT_L(0); PG8_BAR; PG8_MMA(1, 0, At, B0); PG8_MMA(1, 1, At, B1); PG8_BAR; PG8_SCHED;
            } else {
            PG8_LDB(B0, 0, 0); PG8_SCHED; PG8_LDA(At, 0, 0); PG8_STAGE(PG8_SA(1, 1), a1 + hstep, voffA);
            PG8_WAIT_L(8); PG8_BAR; PG8_WAIT_L(0); PG8_MMA(0, 0, At, B0); PG8_BAR; PG8_SCHED;
            PG8_LDB(B1, 0, 1); PG8_STAGE(PG8_SB(0, 0), b2, voffB);
            PG8_BAR; PG8_WAIT_L(0); PG8_MMA(0, 1, At, B1); PG8_BAR;
            PG8_LDA(At, 0, 1); PG8_STAGE(PG8_SA(0, 0), a2, voffA);
            PG8_BAR; PG8_WAIT_L(0); PG8_MMA(1, 0, At, B0); PG8_BAR; PG8_SCHED;
            PG8_STAGE(PG8_SB(0, 1), b2 + hstep, voffB);
            PG8_WAIT_V(6); PG8_BAR; PG8_MMA(1, 1, At, B1); PG8_BAR;
            PG8_LDB(B0, 1, 0); PG8_SCHED; PG8_LDA(At, 1, 0); PG8_STAGE(PG8_SA(0, 1), a2 + hstep, voffA);
            PG8_WAIT_L(8); PG8_BAR; PG8_WAIT_L(0); PG8_MMA(0, 0, At, B0); PG8_BAR; PG8_SCHED;
            PG8_LDB(B1, 1, 1); PG8_STAGE(PG8_SB(1, 0), b3, voffB);
            PG8_BAR; PG8_WAIT_L(0); PG8_MMA(0, 1, At, B1); PG8_BAR;
            PG8_LDA(At, 1, 1); PG8_STAGE(PG8_SA(1, 0), a3, voffA);
            PG8_BAR; PG8_WAIT_L(0); PG8_MMA(1, 0, At, B0); PG8_BAR; PG8_SCHED;
            PG8_STAGE(PG8_SB(1, 1), b3 + hstep, voffB);
            PG8_WAIT_V(6); PG8_BAR; PG8_MMA(1, 1, At, B1); PG8_BAR;
            }
        }
        if constexpr (ALIGN_EPI) { if (wr == 0) PG8_BAR; }
        if constexpr (FP8) asm volatile("s_nop 15\n\ts_nop 7" ::: "memory");
        if constexpr (!Epi::AFTER_DRAIN) { E(acc, cur, wr, wc, fr, fq); S.done(cur); }
        if (!has_next) break;
#pragma unroll
        for (int a = 0; a < 2; ++a)
#pragma unroll
            for (int b = 0; b < 2; ++b)
#pragma unroll
                for (int m = 0; m < 4; ++m)
#pragma unroll
                    for (int n = 0; n < 2; ++n) acc[a][b][m][n] = (f32x4){0.f, 0.f, 0.f, 0.f};
        cur = nxt; cA = nA; cB = nB; ++ui;
        if constexpr (ALIGN_EPI) { if (wr == 1) PG8_BAR; }
    }
    PG8_WAIT_V(0);
    if constexpr (!ALIGN_EPI) { if (wr == 0) PG8_BAR; }
    PG8_BAR;
    if constexpr (Epi::AFTER_DRAIN) { E.fused(acc, cur, wr, wc, fr, fq, lds, wid, lane); S.done(cur); }
#undef PG8_SA
#undef PG8_SB
#undef PG8_STAGE
#undef PG8_LDA
#undef PG8_LDB
#undef PG8_MMA
#undef PG8_WAIT_V
#undef PG8_WAIT_L
#undef PG8_BAR
#undef PG8_SCHED
}
}

#define LAS __attribute__((address_space(3)))
typedef float f32x4 __attribute__((ext_vector_type(4)));
typedef unsigned u32x4 __attribute__((ext_vector_type(4)));
typedef unsigned u32x2 __attribute__((ext_vector_type(2)));
typedef float v16f __attribute__((ext_vector_type(16)));
typedef float v32f __attribute__((ext_vector_type(32)));
typedef unsigned v6u __attribute__((ext_vector_type(6)));
constexpr int NWAVES = 8, NTHREADS = 512;
constexpr int RING_BYTES = 131072, LDS_BYTES = 163840;

typedef __bf16 pk2_bf2 __attribute__((ext_vector_type(2)));
typedef float pk2_f2 __attribute__((ext_vector_type(2)));
__device__ __forceinline__ unsigned pk2(float lo, float hi) { return __builtin_bit_cast(unsigned, __builtin_convertvector((pk2_f2){lo, hi}, pk2_bf2)); }
__device__ __forceinline__ float xchg32(float v) { const unsigned x = __float_as_uint(v); auto r = __builtin_amdgcn_permlane32_swap(x, x, false, false); return __uint_as_float(r[0] ^ r[1] ^ x); }


__device__ __forceinline__ f32x4 modf4(const long long* __restrict__ p) {
    const u32x4 a = *(const u32x4*)p, b = *(const u32x4*)(p + 2);
    f32x4 r;
    r[0] = (float)(int)a.y + (float)a.x * 2.3283064365386963e-10f; r[1] = (float)(int)a.w + (float)a.z * 2.3283064365386963e-10f;
    r[2] = (float)(int)b.y + (float)b.x * 2.3283064365386963e-10f; r[3] = (float)(int)b.w + (float)b.z * 2.3283064365386963e-10f;
    return r;
}
struct Order1 {
    int G, c;
    __device__ __forceinline__ bool next(int i, pg8::Unit& u) const {
        const int L = i * G + c;
        if (L < 1152) { const int xcd = L & 7, off = L >> 3; u.pm = 8 * xcd + (off & 7); u.pn = off >> 3; return true; }
        if (L < 1192) { const int r = L - 1152; u.pm = 64 + (r & 3); const int j = r >> 2; u.pn = j < 8 ? 4 + j : 8 + j; return true; }
        return false;
    }
    __device__ __forceinline__ void a_ready(const pg8::Unit&) const {}
    __device__ __forceinline__ void done(const pg8::Unit&) const {}
};
struct EpiRope {
    static constexpr bool PERM = true, AFTER_DRAIN = false;
    bf16* O; const float* tab; unsigned char* V8;
    __device__ __forceinline__ void operator()(const pg8::f32x4 (&acc)[2][2][4][2], const pg8::Unit& u, int wr, int wc, int fr, int fq) const {
        const int row0 = u.pm * 256 + wr * 64 + fr, col0 = u.pn * 256 + wc * 32 + 8 * fq;
        const size_t off8 = u.pn < 4 ? WS_Q8 : (u.pn < 8 ? WS_K8 : (u.pn < 12 ? WS_V8 : (u.pn < 16 ? WS_SQ8 : (u.pn == 16 ? WS_SK8 : WS_SV8))));
        const int rs8 = u.pn < 16 ? 1024 : 256, c8 = u.pn < 4 ? 0 : (u.pn < 8 ? 1024 : (u.pn < 12 ? 2048 : (u.pn < 16 ? 3072 : (u.pn == 16 ? 4096 : 4352))));
        unsigned char* const d8 = V8 + off8;
        const bool rope = (u.pm < 64) && (u.pn < 8 || (u.pn >= 12 && u.pn <= 16));
        const bool lo_half = fq < 2;
        const float qsc = (u.pm < 64 && (u.pn < 4 || (u.pn >= 12 && u.pn < 16))) ? 1.4426950408889634f : 1.f;
        const int pbase = 8 * (fq & 1);
#pragma unroll
        for (int ai = 0; ai < 2; ++ai)
#pragma unroll
            for (int m = 0; m < 4; ++m) {
                const int row = row0 + ai * 128 + m * 16;
                f32x4 c0 = {1.f, 1.f, 1.f, 1.f}, c1 = c0, s0 = {0.f, 0.f, 0.f, 0.f}, s1 = s0;
                if (rope) { const int s = row & 4095; const int pos = (wc & 1) ? (s & 63) : (s >> 6); const float* tp = tab + pos * 16 + pbase;
                    c0 = *(const f32x4*)tp; c1 = *(const f32x4*)(tp + 4); s0 = *(const f32x4*)(tp + 1024); s1 = *(const f32x4*)(tp + 1028);
                    if (lo_half) { s0 = -s0; s1 = -s1; } }
                bf16* rowp = O + (size_t)row * PW + col0;
#pragma unroll
                for (int bj = 0; bj < 2; ++bj) {
                    f32x4 v0 = acc[ai][bj][m][0], v1 = acc[ai][bj][m][1];
                    if (rope) {
#pragma unroll
                        for (int j = 0; j < 4; ++j) { const float w0 = xchg32(v0[j]), w1 = xchg32(v1[j]); v0[j] = v0[j] * c0[j] + w0 * s0[j]; v1[j] = v1[j] * c1[j] + w1 * s1[j]; }
                    }
                    v0 = v0 * qsc; v1 = v1 * qsc;
                    int a8 = 0, b8 = 0;
                    a8 = __builtin_amdgcn_cvt_pk_fp8_f32(v0[0], v0[1], a8, false); a8 = __builtin_amdgcn_cvt_pk_fp8_f32(v0[2], v0[3], a8, true);
                    b8 = __builtin_amdgcn_cvt_pk_fp8_f32(v1[0], v1[1], b8, false); b8 = __builtin_amdgcn_cvt_pk_fp8_f32(v1[2], v1[3], b8, true);
                    *(u32x2*)(d8 + (size_t)row * rs8 + (col0 - c8) + bj * 128) = (u32x2){(unsigned)a8, (unsigned)b8};
                }
            }
    }
};
struct EpiRes {
    static constexpr bool PERM = true, AFTER_DRAIN = false;
    const float* x; const long long* mod; bf16* x1; unsigned long long* rowss;
    __device__ __forceinline__ void operator()(const pg8::f32x4 (&acc)[2][2][4][2], const pg8::Unit& u, int wr, int wc, int fr, int fq) const {
        const int row0 = u.pm * 256 + wr * 64 + fr, col0 = u.pn * 256 + wc * 32 + 8 * fq; const int b = u.pm >> 4;
        f32x4 g[2][2];
#pragma unroll
        for (int bj = 0; bj < 2; ++bj)
#pragma unroll
            for (int n = 0; n < 2; ++n) g[bj][n] = modf4(mod + (size_t)b * MODW + 2 * D + col0 + bj * 128 + n * 4);
#pragma unroll
        for (int ai = 0; ai < 2; ++ai) {
                f32x4 xs[4][2][2];
#pragma unroll
                for (int mm = 0; mm < 4; ++mm) { const size_t off = (size_t)(row0 + ai * 128 + mm * 16) * D + col0;
#pragma unroll
                    for (int bj = 0; bj < 2; ++bj)
#pragma unroll
                        for (int n = 0; n < 2; ++n) xs[mm][bj][n] = __builtin_nontemporal_load((const f32x4*)(x + off + bj * 128 + n * 4)); }
#pragma unroll
                for (int mm = 0; mm < 4; ++mm) { const size_t off = (size_t)(row0 + ai * 128 + mm * 16) * D + col0;
                    float ssr = 0.f;
#pragma unroll
                    for (int bj = 0; bj < 2; ++bj) { const f32x4 v0 = xs[mm][bj][0] + g[bj][0] * acc[ai][bj][mm][0], v1 = xs[mm][bj][1] + g[bj][1] * acc[ai][bj][mm][1];
                        u32x4 w; w.x = pk2(v0[0], v0[1]); w.y = pk2(v0[2], v0[3]); w.z = pk2(v1[0], v1[1]); w.w = pk2(v1[2], v1[3]);
                        ssr += ((v0[0] * v0[0] + v0[1] * v0[1]) + (v0[2] * v0[2] + v0[3] * v0[3])) + ((v1[0] * v1[0] + v1[1] * v1[1]) + (v1[2] * v1[2] + v1[3] * v1[3]));
                        *(u32x4*)(x1 + off + bj * 128) = w; }
                    ssr += __shfl_xor(ssr, 16); ssr += __shfl_xor(ssr, 32);
                    if (fq == 0) atomicAdd(rowss + (row0 + ai * 128 + mm * 16), (unsigned long long)__float2ll_rn(ssr * 4294967296.f)); }
                asm volatile("" ::: "memory"); }
    }
};
struct EpiQ2 {
    static constexpr bool PERM = true, AFTER_DRAIN = false;
    bf16* O; const unsigned long long* rowss; const float* qbias;
    __device__ __forceinline__ void operator()(const pg8::f32x4 (&acc)[2][2][4][2], const pg8::Unit& u, int wr, int wc, int fr, int fq) const {
        const int row0 = u.pm * 256 + wr * 64 + fr, col0 = (u.pn & 7) * 256 + wc * 32 + 8 * fq; const int b = u.pm >> 4;
        f32x4 bs[2][2];
#pragma unroll
        for (int bj = 0; bj < 2; ++bj)
#pragma unroll
            for (int n = 0; n < 2; ++n) bs[bj][n] = *(const f32x4*)(qbias + (size_t)b * D + col0 + bj * 128 + n * 4);
#pragma unroll
        for (int ai = 0; ai < 2; ++ai)
#pragma unroll
            for (int m = 0; m < 4; ++m) { const int row = row0 + ai * 128 + m * 16;
                const unsigned long long sv = rowss[row];
                const float ss = (float)(int)(unsigned)(sv >> 32) + (float)(unsigned)sv * 2.3283064365386963e-10f;
                const float rstd = rsqrtf(ss * (1.f / D) + EPS);
                bf16* rowp = O + (size_t)row * D + col0;
#pragma unroll
                for (int bj = 0; bj < 2; ++bj) { const f32x4 v0 = acc[ai][bj][m][0] * rstd + bs[bj][0], v1 = acc[ai][bj][m][1] * rstd + bs[bj][1];
                    u32x4 w; w.x = pk2(v0[0], v0[1]); w.y = pk2(v0[2], v0[3]); w.z = pk2(v1[0], v1[1]); w.w = pk2(v1[2], v1[3]);
                    *(u32x4*)(rowp + bj * 128) = w; } }
    }
};
struct Order6 {
    pg8::StaticOrder S;
    __device__ __forceinline__ bool next(int i, pg8::Unit& u) const { if (!S.next(i, u)) return false; u.pn += 8 * (u.pm >> 4); return true; }
    __device__ __forceinline__ void a_ready(const pg8::Unit&) const {}
    __device__ __forceinline__ void done(const pg8::Unit&) const {}
};
struct EpiQ {
    static constexpr bool PERM = true, AFTER_DRAIN = false;
    bf16* O;
    __device__ __forceinline__ void operator()(const pg8::f32x4 (&acc)[2][2][4][2], const pg8::Unit& u, int wr, int wc, int fr, int fq) const {
        asm volatile("s_nop 15\n\ts_nop 7" ::: "memory");
        const int row0 = u.pm * 256 + wr * 64 + fr, col0 = u.pn * 256 + wc * 32 + 8 * fq;
#pragma unroll
        for (int ai = 0; ai < 2; ++ai)
#pragma unroll
            for (int m = 0; m < 4; ++m) { bf16* rowp = O + (size_t)(row0 + ai * 128 + m * 16) * D + col0;
#pragma unroll
                for (int bj = 0; bj < 2; ++bj) { const f32x4 v0 = acc[ai][bj][m][0], v1 = acc[ai][bj][m][1];
                    u32x4 w; w.x = pg8::cvt_pk_bf16(v0[0], v0[1]); w.y = pg8::cvt_pk_bf16(v0[2], v0[3]); w.z = pg8::cvt_pk_bf16(v1[0], v1[1]); w.w = pg8::cvt_pk_bf16(v1[2], v1[3]);
                    *(u32x4*)(rowp + bj * 128) = w; } }
    }
};

struct Args { const float* in[22]; float* out; unsigned char* ws; int ph_lo, ph_hi, tab_r0; };
constexpr int TAB_R0 = 20480;

__device__ __forceinline__ void p0_transpose_item(const float* __restrict__ W, int K, int N, bf16* __restrict__ WT, LAS float* scr, int item, int lane) {
    const int nblk = N / 32, kb = item / nblk, nb = item % nblk, k0 = 64 * kb, n0 = 32 * nb;
    float t_[32];
    const float* wp = W + (size_t)(k0 + (lane >> 5)) * N + n0 + (lane & 31);
#pragma unroll
    for (int i = 0; i < 32; ++i) t_[i] = __builtin_nontemporal_load(wp + (size_t)(2 * i) * N);
#pragma unroll
    for (int i = 0; i < 32; ++i) scr[(2 * i + (lane >> 5)) * 33 + (lane & 31)] = t_[i];
    asm volatile("s_waitcnt lgkmcnt(0)" ::: "memory");
    const int c = lane & 7;
#pragma unroll
    for (int j = 0; j < 4; ++j) { const int n = (lane >> 3) + 8 * j; const LAS float* s = scr + (8 * c) * 33 + n;
        u32x4 o; o.x = pk2(s[0 * 33], s[1 * 33]); o.y = pk2(s[2 * 33], s[3 * 33]); o.z = pk2(s[4 * 33], s[5 * 33]); o.w = pk2(s[6 * 33], s[7 * 33]);
        *(u32x4*)(WT + (size_t)(n0 + n) * K + k0 + 8 * c) = o; }
    asm volatile("s_waitcnt lgkmcnt(0)" ::: "memory");
}
__device__ __forceinline__ void p0_transpose_item8(const float* __restrict__ W, int K, int N, unsigned char* __restrict__ WT, LAS float* scr, int item, int lane, float SC) {
    const int nblk = N / 32, kb = item / nblk, nb = item % nblk, k0 = 64 * kb, n0 = 32 * nb;
    float t_[32];
    const float* wp = W + (size_t)(k0 + (lane >> 5)) * N + n0 + (lane & 31);
#pragma unroll
    for (int i = 0; i < 32; ++i) t_[i] = __builtin_nontemporal_load(wp + (size_t)(2 * i) * N);
#pragma unroll
    for (int i = 0; i < 32; ++i) scr[(2 * i + (lane >> 5)) * 33 + (lane & 31)] = t_[i] * SC;
    asm volatile("s_waitcnt lgkmcnt(0)" ::: "memory");
    const int c = lane & 7;
#pragma unroll
    for (int j = 0; j < 4; ++j) { const int n = (lane >> 3) + 8 * j; const LAS float* s = scr + (8 * c) * 33 + n;
        int a8 = 0, b8 = 0;
        a8 = __builtin_amdgcn_cvt_pk_fp8_f32(s[0 * 33], s[1 * 33], a8, false); a8 = __builtin_amdgcn_cvt_pk_fp8_f32(s[2 * 33], s[3 * 33], a8, true);
        b8 = __builtin_amdgcn_cvt_pk_fp8_f32(s[4 * 33], s[5 * 33], b8, false); b8 = __builtin_amdgcn_cvt_pk_fp8_f32(s[6 * 33], s[7 * 33], b8, true);
        *(u32x2*)(WT + (size_t)(n0 + n) * K + k0 + 8 * c) = (u32x2){(unsigned)a8, (unsigned)b8}; }
    asm volatile("s_waitcnt lgkmcnt(0)" ::: "memory");
}
__device__ __forceinline__ void p0_enc_row(const Args& a, int r, const f32x4 (&v)[8], int lane) {
    unsigned char* ws = a.ws;
    const bool isv = r >= 16384; const int row = isv ? r - 16384 : r;
    float mx = 0.f;
#pragma unroll
    for (int j = 0; j < 8; ++j) mx = fmaxf(fmaxf(mx, fmaxf(fabsf(v[j][0]), fabsf(v[j][1]))), fmaxf(fabsf(v[j][2]), fabsf(v[j][3])));
    mx = wave_max(mx);
    if (!isv) {
        const float qs = mx > 0.f ? 7.5f / mx : 1.f;
        v16f xa, xb;
#pragma unroll
        for (int j = 0; j < 4; ++j)
#pragma unroll
            for (int k = 0; k < 4; ++k) { const float e0_ = v[j][k] * qs, e1_ = v[4 + j][k] * qs;
                if (((4 * j + k) & 1) == 0) { xa[(4 * j + k) >> 1] = e0_; xa[(16 + 4 * j + k) >> 1] = e1_; } else { xb[(4 * j + k) >> 1] = e0_; xb[(16 + 4 * j + k) >> 1] = e1_; } }
        const v6u p = __builtin_amdgcn_cvt_scalef32_2xpk16_fp6_f32(xa, xb, 1.0f);
        unsigned char* dst = ws + WS_U + (size_t)row * 1536;
        *(u32x4*)(dst + lane * 16) = (u32x4){p[0], p[1], p[2], p[3]}; *(u32x2*)(dst + 1024 + lane * 8) = (u32x2){p[4], p[5]};
        if (lane == 0) ((float*)(ws + WS_U + 32 * MiB))[row] = mx > 0.f ? mx * (1.f / 7.5f) : 1.f;
    } else {
        const float qs = mx > 0.f ? 6.f / mx : 1.f;
        u32x4 p = {0u, 0u, 0u, 0u};
#define P0_FP4_DW(d, ja, jb) do { \
        p[d] = __builtin_amdgcn_cvt_scalef32_pk_fp4_f32(p[d], v[ja][0] * qs, v[ja][1] * qs, 1.0f, 0); p[d] = __builtin_amdgcn_cvt_scalef32_pk_fp4_f32(p[d], v[ja][2] * qs, v[ja][3] * qs, 1.0f, 1); \
        p[d] = __builtin_amdgcn_cvt_scalef32_pk_fp4_f32(p[d], v[jb][0] * qs, v[jb][1] * qs, 1.0f, 2); p[d] = __builtin_amdgcn_cvt_scalef32_pk_fp4_f32(p[d], v[jb][2] * qs, v[jb][3] * qs, 1.0f, 3); } while (0)
        P0_FP4_DW(0, 0, 1); P0_FP4_DW(1, 2, 3); P0_FP4_DW(2, 4, 5); P0_FP4_DW(3, 6, 7);
#undef P0_FP4_DW
        *(u32x4*)(ws + WS_V + (size_t)row * 1024 + lane * 16) = p;
        if (lane == 0) ((float*)(ws + WS_V + 32 * MiB))[row] = mx > 0.f ? mx * (1.f / 6.f) : 1.f;
    }
}
__device__ __forceinline__ const float* p0_tab_src(const Args& a, int r, int lane) { return (r >= 16384 ? a.in[20] + (size_t)(r - 16384) * D : a.in[19] + (size_t)r * D) + lane * 4; }
#define P0_TAB_LOAD(v_, r_, ok_) do { const float* s_ = p0_tab_src(a, (ok_) ? (r_) : r, lane); _Pragma("unroll") for (int j = 0; j < 8; ++j) v_[j] = __builtin_nontemporal_load((const f32x4*)(s_ + 256 * j)); } while (0)
template <int NR>
__device__ __forceinline__ void p0_tables(const Args& a, int r0, int r1, int w, int nw, int lane) {
    for (int r = r0 + w; r < r1; r += NR * nw) {
        const int rb = r + nw, rc = r + 2 * nw, rd = r + 3 * nw;
        const bool hb = NR > 1 && rb < r1, hc = NR > 2 && rc < r1, hd = NR > 2 && rd < r1;
        f32x4 va[8], vb[8], vc[8], vd[8];
        P0_TAB_LOAD(va, r, true);
        if (NR > 1) P0_TAB_LOAD(vb, rb, hb);
        if (NR > 2) { P0_TAB_LOAD(vc, rc, hc); P0_TAB_LOAD(vd, rd, hd); }
        p0_enc_row(a, r, va, lane);
        if (hb) p0_enc_row(a, rb, vb, lane);
        if (hc) p0_enc_row(a, rc, vc, lane);
        if (hd) p0_enc_row(a, rd, vd, lane);
    }
}
__device__ __forceinline__ void p0_prep(const Args& a, LAS unsigned char* lds, int gw, int NGW, int wave, int lane) {
    unsigned char* ws = a.ws;
    unsigned long long* MOD = (unsigned long long*)(ws + WS_MOD);
    {
        const int vcu = gw >> 3, G_ = NGW >> 3, tid = wave * 64 + lane;
        LAS float* part = (LAS float*)lds;
        for (int item = vcu; item < 192; item += G_) {
            const int nc = item % 48, kc = (item / 48) * 8 + wave, k0 = kc * 64, n0 = nc * 256 + lane * 4;
            float sv[5];
#pragma unroll
            for (int r = 0; r < 5; ++r) { const float v = r < 4 ? a.in[1][r * D + k0 + lane] : a.in[3][k0 + lane]; sv[r] = v / (1.f + __expf(-v)); }
            f32x4 acc[5];
#pragma unroll
            for (int r = 0; r < 5; ++r) acc[r] = (f32x4){0.f, 0.f, 0.f, 0.f};
            const float* wp = a.in[4] + (size_t)k0 * MODW + n0;
#pragma unroll 8
            for (int kk = 0; kk < 64; ++kk) { const f32x4 w = __builtin_nontemporal_load((const f32x4*)(wp + (size_t)kk * MODW));
#pragma unroll
                for (int r = 0; r < 5; ++r) { const float s = __int_as_float(__builtin_amdgcn_readlane(__float_as_int(sv[r]), kk)); acc[r] += w * s; } }
            if (kc == 0) { const f32x4 bb = *(const f32x4*)(a.in[5] + n0);
#pragma unroll
                for (int r = 0; r < 5; ++r) acc[r] += bb; }
#pragma unroll
            for (int r = 0; r < 5; ++r) *(LAS f32x4*)(part + (wave * 5 + r) * 256 + lane * 4) = acc[r];
            __syncthreads();
            for (int o = tid; o < 5 * 256; o += NTHREADS) { const int r = o >> 8, c = o & 255;
                float sum = part[(0 * 5 + r) * 256 + c];
#pragma unroll
                for (int w = 1; w < 8; ++w) sum += part[(w * 5 + r) * 256 + c];
                atomicAdd(MOD + (size_t)r * MODW + nc * 256 + c, (unsigned long long)__float2ll_rn(sum * 4294967296.f)); }
            __syncthreads();
        }
    }
    const int ngv_ = (NGW >> 3) > 192 ? 192 * 8 : NGW;
    const int s0_ = gw < ngv_ ? gw * 3 : ngv_ * 3 + (gw - ngv_) * 7, ns_ = gw < ngv_ ? 3 : 7, NSL_ = ngv_ * 3 + (NGW - ngv_) * 7;
    {
        LAS float* scr = (LAS float*)(lds + wave * 16384);
        constexpr int I_IN = (D / 64) * (PW / 32), I_O = (D / 64) * (D / 32);
        for (int sl = s0_; sl < s0_ + ns_; ++sl)
        for (int it = sl; it < I_IN + 2 * I_O; it += NSL_) {
            int r = it;
            if (r < I_IN) { p0_transpose_item8(a.in[7], D, PW, ws + WS_WIN, scr, r, lane, 32.f); continue; } r -= I_IN;
            if (r < I_O) { p0_transpose_item8(a.in[15], D, D, ws + WS_WOUT, scr, r, lane, 32.f); continue; } r -= I_O;
            p0_transpose_item(a.in[17], D, D, (bf16*)(ws + WS_WQ), scr, r, lane);
        }
    }
    for (int sl = s0_; sl < s0_ + ns_; ++sl) p0_tables<2>(a, 0, a.tab_r0, sl, NSL_, lane);
    for (int sl = s0_; sl < s0_ + ns_; ++sl)
    for (int ch = sl; ch < 16 * 128 * 128 / 512; ch += NSL_) {
        const float* src = a.in[18] + (size_t)ch * 512 + lane * 8; const f32x4 v0 = *(const f32x4*)src, v1 = *(const f32x4*)(src + 4);
        u32x4 o; o.x = pk2(v0[0], v0[1]); o.y = pk2(v0[2], v0[3]); o.z = pk2(v1[0], v1[1]); o.w = pk2(v1[2], v1[3]);
        *(u32x4*)((bf16*)(ws + WS_SK) + (size_t)ch * 512 + lane * 8) = o;
    }
    if (gw == NGW - 1) { float* tab = (float*)(ws + WS_ROPE);
        for (int i = lane; i < 1024; i += 64) { const int pos = i >> 4, p = i & 15; const float f = powf(10000.f, -(float)p / 16.f); const float ang = (float)pos * f; tab[i] = cosf(ang); tab[1024 + i] = sinf(ang); } }
}
__device__ __forceinline__ void p1_fold(const Args& a, LAS unsigned char* lds, int gw, int NGW, int tid, int lane) {
    unsigned char* ws = a.ws;
    const long long* mod = (const long long*)(ws + WS_MOD);
    const bf16* WQT = (const bf16*)(ws + WS_WQ); bf16* WQB = (bf16*)(ws + WS_WQB);
    float* QB = (float*)(ws + WS_QBIAS);
    const float* gain = a.in[16];
    LAS float* Al = (LAS float*)lds; LAS float* Sl = Al + NB * D;
#pragma unroll
    for (int i = 0; i < 4; ++i) { const int idx = (i * NTHREADS + tid) * 4, b = idx >> 11, k = idx & (D - 1);
        const f32x4 am = *(const f32x4*)(gain + k) * (modf4(mod + (size_t)b * MODW + 4 * D + k) + 1.f), sh = modf4(mod + (size_t)b * MODW + 3 * D + k);
        *(LAS f32x4*)(Al + idx) = am; *(LAS f32x4*)(Sl + idx) = sh;
        if (blockIdx.x == 0) { *(f32x4*)((float*)(ws + WS_AMSH) + idx) = am; *(f32x4*)((float*)(ws + WS_AMSH) + NB * D + idx) = sh; } }
    __syncthreads();
    for (int n = gw; n < D; n += NGW) {
        f32x4 w[8];
#pragma unroll
        for (int j = 0; j < 8; ++j) { const u32x2 r = *(const u32x2*)(WQT + (size_t)n * D + lane * 4 + 256 * j);
            w[j] = (f32x4){__uint_as_float(r.x << 16), __uint_as_float(r.x & 0xffff0000u), __uint_as_float(r.y << 16), __uint_as_float(r.y & 0xffff0000u)}; }
#pragma unroll 1
        for (int b = 0; b < NB; ++b) {
            float bsum = 0.f;
#pragma unroll
            for (int j = 0; j < 8; ++j) { const f32x4 am = *(LAS const f32x4*)(Al + b * D + lane * 4 + 256 * j), sh = *(LAS const f32x4*)(Sl + b * D + lane * 4 + 256 * j);
                const f32x4 y = w[j] * am; bsum += (w[j][0] * sh[0] + w[j][1] * sh[1]) + (w[j][2] * sh[2] + w[j][3] * sh[3]);
                u32x2 o; o.x = pk2(y[0], y[1]); o.y = pk2(y[2], y[3]); *(u32x2*)(WQB + ((size_t)b * D + n) * D + lane * 4 + 256 * j) = o; }
            bsum = wave_sum(bsum);
            if (lane == 0) QB[(size_t)b * D + n] = bsum;
        }
    }
}
#define NORM_AB(gain, mrow, scale_off, shift_off) do { _Pragma("unroll") for (int j = 0; j < 8; ++j) { const f32x4 g4 = *(const f32x4*)((gain) + lane * 4 + 256 * j); \
        A_[j] = g4 * (modf4((mrow) + (scale_off) + 256 * j) + 1.f); B_[j] = modf4((mrow) + (shift_off) + 256 * j); } } while (0)
#define NORM_OUT(v_, ss_, o_) do { const float rstd_ = rsqrtf(wave_sum(ss_) * (1.f / D) + EPS); _Pragma("unroll") for (int j = 0; j < 8; ++j) { const f32x4 y = v_[j] * rstd_ * A_[j] + B_[j]; \
        u32x2 w; w.x = pk2(y[0], y[1]); w.y = pk2(y[2], y[3]); *(u32x2*)((o_) + 256 * j) = w; } } while (0)
#define NORM_OUT8(v_, ss_, o_) do { const float rstd_ = rsqrtf(wave_sum(ss_) * (1.f / D) + EPS); _Pragma("unroll") for (int j = 0; j < 8; ++j) { const f32x4 y = v_[j] * rstd_ * A_[j] + B_[j]; \
        int w8 = 0; w8 = __builtin_amdgcn_cvt_pk_fp8_f32(y[0], y[1], w8, false); w8 = __builtin_amdgcn_cvt_pk_fp8_f32(y[2], y[3], w8, true); *(int*)((o_) + 256 * j) = w8; } } while (0)
__device__ __forceinline__ void norm_rows(const float* __restrict__ X, int nrows, const float* __restrict__ gain, const long long* __restrict__ mod, int shift_off, int scale_off, int fixed_mod_row, unsigned char* __restrict__ out, int gw, int NGW, int lane) {
    for (int ra = gw; ra < nrows; ra += 2 * NGW) {
        const int rb = ra + NGW; const bool hb = rb < nrows;
        const float* x0 = X + (size_t)ra * D + lane * 4; const float* x1 = X + (size_t)(hb ? rb : ra) * D + lane * 4;
        f32x4 v0[8], v1[8]; float s0 = 0.f, s1 = 0.f;
#pragma unroll
        for (int j = 0; j < 8; ++j) v0[j] = __builtin_nontemporal_load((const f32x4*)(x0 + 256 * j));
#pragma unroll
        for (int j = 0; j < 8; ++j) v1[j] = __builtin_nontemporal_load((const f32x4*)(x1 + 256 * j));
        const int ma = fixed_mod_row >= 0 ? fixed_mod_row : (ra >> 12), mb = fixed_mod_row >= 0 ? fixed_mod_row : (rb >> 12);
        f32x4 A_[8], B_[8];
        NORM_AB(gain, mod + (size_t)ma * MODW + lane * 4, scale_off, shift_off);
#pragma unroll
        for (int j = 0; j < 8; ++j) { s0 += (v0[j][0] * v0[j][0] + v0[j][1] * v0[j][1]) + (v0[j][2] * v0[j][2] + v0[j][3] * v0[j][3]); s1 += (v1[j][0] * v1[j][0] + v1[j][1] * v1[j][1]) + (v1[j][2] * v1[j][2] + v1[j][3] * v1[j][3]); }
        NORM_OUT8(v0, s0, out + (size_t)ra * D + lane * 4);
        if (hb) { if (mb != ma) NORM_AB(gain, mod + (size_t)mb * MODW + lane * 4, scale_off, shift_off);
            NORM_OUT8(v1, s1, out + (size_t)rb * D + lane * 4); }
    }
}
__device__ __forceinline__ void norm_rows_batch(const float* __restrict__ X, const float* __restrict__ gain, const long long* __restrict__ mod, int shift_off, int scale_off, unsigned char* __restrict__ out, int gw, int NGW, int lane) {
    const int wpb = NGW / NB, b = gw / wpb, w = gw - b * wpb;
    if (b >= NB) return;
    f32x4 A_[8], B_[8];
    NORM_AB(gain, mod + (size_t)b * MODW + lane * 4, scale_off, shift_off);
    for (int r = w; r < S; r += 2 * wpb) {
        const int ra = b * S + r, rb = ra + wpb; const bool hb = r + wpb < S;
        const float* x0 = X + (size_t)ra * D + lane * 4; const float* x1 = X + (size_t)(hb ? rb : ra) * D + lane * 4;
        f32x4 v0[8], v1[8]; float s0 = 0.f, s1 = 0.f;
#pragma unroll
        for (int j = 0; j < 8; ++j) v0[j] = __builtin_nontemporal_load((const f32x4*)(x0 + 256 * j));
#pragma unroll
        for (int j = 0; j < 8; ++j) v1[j] = __builtin_nontemporal_load((const f32x4*)(x1 + 256 * j));
#pragma unroll
        for (int j = 0; j < 8; ++j) { s0 += (v0[j][0] * v0[j][0] + v0[j][1] * v0[j][1]) + (v0[j][2] * v0[j][2] + v0[j][3] * v0[j][3]); s1 += (v1[j][0] * v1[j][0] + v1[j][1] * v1[j][1]) + (v1[j][2] * v1[j][2] + v1[j][3] * v1[j][3]); }
        NORM_OUT8(v0, s0, out + (size_t)ra * D + lane * 4);
        if (hb) NORM_OUT8(v1, s1, out + (size_t)rb * D + lane * 4);
    }
}
#undef NORM_OUT8

#define NORM_CVT(v_, w_, ss_) do { _Pragma("unroll") for (int j = 0; j < 8; ++j) { \
        v_[j] = (f32x4){__uint_as_float(w_[j].x << 16), __uint_as_float(w_[j].x & 0xffff0000u), __uint_as_float(w_[j].y << 16), __uint_as_float(w_[j].y & 0xffff0000u)}; \
        ss_ += (v_[j][0] * v_[j][0] + v_[j][1] * v_[j][1]) + (v_[j][2] * v_[j][2] + v_[j][3] * v_[j][3]); } } while (0)
__device__ __forceinline__ void norm_rows_bf16(const bf16* __restrict__ X, int nrows, const float* __restrict__ gain, const long long* __restrict__ mod, int shift_off, int scale_off, bf16* __restrict__ out, int gw, int NGW, int lane) {
    for (int ra = gw; ra < nrows; ra += 4 * NGW) {
        const int rb = ra + NGW, rc = ra + 2 * NGW, rd = ra + 3 * NGW; const bool hb = rb < nrows, hc = rc < nrows, hd = rd < nrows;
        u32x2 w0[8], w1[8], w2[8], w3[8];
        { const bf16* x0 = X + (size_t)ra * D + lane * 4; const bf16* x1 = X + (size_t)(hb ? rb : ra) * D + lane * 4; const bf16* x2 = X + (size_t)(hc ? rc : ra) * D + lane * 4; const bf16* x3 = X + (size_t)(hd ? rd : ra) * D + lane * 4;
#pragma unroll
          for (int j = 0; j < 8; ++j) w0[j] = *(const u32x2*)(x0 + 256 * j);
#pragma unroll
          for (int j = 0; j < 8; ++j) w1[j] = *(const u32x2*)(x1 + 256 * j);
#pragma unroll
          for (int j = 0; j < 8; ++j) w2[j] = *(const u32x2*)(x2 + 256 * j);
#pragma unroll
          for (int j = 0; j < 8; ++j) w3[j] = *(const u32x2*)(x3 + 256 * j); }
        f32x4 A_[8], B_[8]; f32x4 v_[8]; float ss;
        int mcur = ra >> 12;
        NORM_AB(gain, mod + (size_t)mcur * MODW + lane * 4, scale_off, shift_off);
        ss = 0.f; NORM_CVT(v_, w0, ss); NORM_OUT(v_, ss, out + (size_t)ra * D + lane * 4);
        if (hb) { if ((rb >> 12) != mcur) { mcur = rb >> 12; NORM_AB(gain, mod + (size_t)mcur * MODW + lane * 4, scale_off, shift_off); }
            ss = 0.f; NORM_CVT(v_, w1, ss); NORM_OUT(v_, ss, out + (size_t)rb * D + lane * 4); }
        if (hc) { if ((rc >> 12) != mcur) { mcur = rc >> 12; NORM_AB(gain, mod + (size_t)mcur * MODW + lane * 4, scale_off, shift_off); }
            ss = 0.f; NORM_CVT(v_, w2, ss); NORM_OUT(v_, ss, out + (size_t)rc * D + lane * 4); }
        if (hd) { if ((rd >> 12) != mcur) { mcur = rd >> 12; NORM_AB(gain, mod + (size_t)mcur * MODW + lane * 4, scale_off, shift_off); }
            ss = 0.f; NORM_CVT(v_, w3, ss); NORM_OUT(v_, ss, out + (size_t)rd * D + lane * 4); }
    }
}
#undef NORM_CVT
#undef NORM_AB
#undef NORM_OUT


#define XB_TMO      128
#define XB_XCNT(j)  (256  + 64 * (j))
#define XB_XSUB(j)  (1280 + 64 * (j))
#define XB_XGEN(j)  (2304 + 64 * (j))
#define XB_TOP      3328
#define XB_TOPGEN   3392
#define XCD_BAR_WORDS 3456
#define XB_SPIN_CAP (1u << 18)

__device__ __forceinline__ unsigned xb_ld(unsigned* p)              { return __hip_atomic_load(p, __ATOMIC_RELAXED, __HIP_MEMORY_SCOPE_AGENT); }
__device__ __forceinline__ unsigned xb_add(unsigned* p, unsigned v) { return __hip_atomic_fetch_add(p, v, __ATOMIC_RELAXED, __HIP_MEMORY_SCOPE_AGENT); }
__device__ __forceinline__ unsigned xb_xcc_id() { return (unsigned)__builtin_amdgcn_s_getreg((3 << 11) | 20) & 0xFu; }
#define XB_SPIN(cond, bar) do { unsigned _sp = 0; while (cond) { __builtin_amdgcn_s_sleep(1); \
    if ((++_sp & 255u) == 0u) { if (xb_ld(&(bar)[XB_TMO])) break; if (_sp > XB_SPIN_CAP) { atomicAdd(&(bar)[XB_TMO], 1u); break; } } } } while (0)

struct XcdBarrier {
    unsigned* bar; unsigned x;
    volatile LAS unsigned* st;
};

__device__ __forceinline__ XcdBarrier xcd_barrier_post(unsigned* bar, volatile LAS unsigned* st) {
    XcdBarrier b; b.bar = bar; b.x = xb_xcc_id(); b.st = st;
    if (threadIdx.x == 0) (void)xb_add(&bar[XB_XCNT(b.x)], 1u);
    return b;
}
__device__ __forceinline__ void xcd_barrier_complete(unsigned* bar, unsigned x, unsigned& nloc, unsigned& nx) {
    const unsigned G = gridDim.x * gridDim.y * gridDim.z;
    unsigned sum, cnt, mine, sp = 0u;
    for (;;) {
        sum = 0u; cnt = 0u; mine = 0u;
#pragma unroll
        for (unsigned j = 0; j < 16; ++j) { const unsigned c = xb_ld(&bar[XB_XCNT(j)]); sum += c; cnt += (c > 0u) ? 1u : 0u; mine = (j == x) ? c : mine; }
        if (sum == G) break;
        __builtin_amdgcn_s_sleep(1);
        if ((++sp & 255u) == 0u) { if (xb_ld(&bar[XB_TMO])) break; if (sp > XB_SPIN_CAP) { atomicAdd(&bar[XB_TMO], 1u); break; } }
    }
    nloc = mine > 0u ? mine : 1u; nx = cnt > 0u ? cnt : 1u;
}

__device__ __forceinline__ void xcd_barrier(const XcdBarrier& b) {
    asm volatile("s_waitcnt vmcnt(0)" ::: "memory");
    __syncthreads();
    if (threadIdx.x == 0) {
        unsigned* bar = b.bar;
        __builtin_amdgcn_s_waitcnt(0);
        unsigned nloc = b.st[0], nx = b.st[1];
        if (nloc == 0u) { xcd_barrier_complete(bar, b.x, nloc, nx); b.st[0] = nloc; b.st[1] = nx; }
        const unsigned old = xb_add(&bar[XB_XSUB(b.x)], 1u);
        const unsigned gen = old / nloc;
        if (old + 1u == (gen + 1u) * nloc) {
            __builtin_amdgcn_fence(__ATOMIC_RELEASE, "agent");
            asm volatile("s_waitcnt vmcnt(0)" ::: "memory");
            const unsigned og = xb_add(&bar[XB_TOP], 1u);
            const unsigned tg = og / nx;
            if (og + 1u == (tg + 1u) * nx) xb_add(&bar[XB_TOPGEN], 1u);
            else XB_SPIN(xb_ld(&bar[XB_TOPGEN]) == tg, bar);
            __builtin_amdgcn_fence(__ATOMIC_ACQUIRE, "agent");
            xb_add(&bar[XB_XGEN(b.x)], 1u);
            asm volatile("s_waitcnt vmcnt(0)" ::: "memory");
        } else {
            XB_SPIN(xb_ld(&bar[XB_XGEN(b.x)]) == gen, bar);
            __builtin_amdgcn_fence(__ATOMIC_ACQUIRE, "agent");
            asm volatile("s_waitcnt vmcnt(0)" ::: "memory");
        }
    }
    __syncthreads();
}

typedef float f32x16 __attribute__((ext_vector_type(16)));
typedef short s16x8 __attribute__((ext_vector_type(8)));
typedef short s16x4 __attribute__((ext_vector_type(4)));
__device__ __forceinline__ int crow(int r, int hi) { return (r & 3) + 8 * (r >> 2) + 4 * hi; }
__device__ __forceinline__ s16x4 vtr(LAS const unsigned char* p) { return __builtin_bit_cast(s16x4, __builtin_amdgcn_ds_read_tr16_b64_v4i16((LAS s16x4*)p)); }
typedef float att_f32x2 __attribute__((ext_vector_type(2))); typedef __bf16 att_bf16x2 __attribute__((ext_vector_type(2)));
__device__ __forceinline__ unsigned cvtpk(float lo, float hi) { const att_f32x2 v = {lo, hi}; const att_bf16x2 b = __builtin_convertvector(v, att_bf16x2); return __builtin_bit_cast(unsigned, b); }
constexpr float ATT_C2 = 0.125f * 1.4426950408889634f;

__device__ __forceinline__ float max3f(float a, float b, float c) { float r; asm("v_max3_f32 %0, %1, %2, %3" : "=v"(r) : "v"(a), "v"(b), "v"(c)); return r; }
__device__ __forceinline__ float max2f(float a, float b) { float r; asm("v_max_f32 %0, %1, %2" : "=v"(r) : "v"(a), "v"(b)); return r; }
__device__ __forceinline__ float max16(const f32x16& p) {
    float ra, rb;
    asm volatile("v_max3_f32 %0, %2, %3, %4\n\tv_max3_f32 %1, %10, %11, %12\n\tv_max3_f32 %0, %0, %5, %6\n\tv_max3_f32 %1, %1, %13, %14\n\t"
                 "v_max3_f32 %0, %0, %7, %8\n\tv_max3_f32 %1, %1, %15, %16\n\tv_max_f32 %0, %0, %9\n\tv_max_f32 %1, %1, %17\n\tv_max_f32 %0, %0, %1"
                 : "=&v"(ra), "=&v"(rb) : "v"(p[0]), "v"(p[1]), "v"(p[2]), "v"(p[3]), "v"(p[4]), "v"(p[5]), "v"(p[6]), "v"(p[7]), "v"(p[8]), "v"(p[9]), "v"(p[10]), "v"(p[11]), "v"(p[12]), "v"(p[13]), "v"(p[14]), "v"(p[15]));
    return ra;
}
typedef float att_f2 __attribute__((ext_vector_type(2)));
__device__ __forceinline__ att_f2 pkadd(att_f2 a, att_f2 b) { att_f2 r; asm("v_pk_add_f32 %0, %1, %2" : "=v"(r) : "v"(a), "v"(b)); return r; }
template <int NBLK> struct RowSt { f32x16 o[NBLK]; f32x16 negm; float m, l; att_f2 l2; s16x8 q[4]; };

#define ATT_VREAD(buf, blk) do { _Pragma("unroll") for (int ks_ = 0; ks_ < 4; ++ks_) { buf[2 * ks_] = vtr(vbp + (blk) * 4096 + ks_ * 1024); buf[2 * ks_ + 1] = vtr(vbp + (blk) * 4096 + ks_ * 1024 + 512); } } while (0)
#define ATT_PV(buf, blk) do { _Pragma("unroll") for (int ks_ = 0; ks_ < 4; ++ks_) { const s16x4 lo_ = buf[2 * ks_], hh_ = buf[2 * ks_ + 1]; \
        const s16x8 vf_ = {lo_[0], lo_[1], lo_[2], lo_[3], hh_[0], hh_[1], hh_[2], hh_[3]}; \
        st.o[blk] = __builtin_amdgcn_mfma_f32_32x32x16_bf16(__builtin_bit_cast(s16x8, pw[ks_]), vf_, st.o[blk], 0, 0, 0); } } while (0)
template <int NBLK, bool MASK, int BOFF>
__device__ __forceinline__ void attn_tile(RowSt<NBLK>& st, LAS const unsigned char* Kt, LAS const unsigned char* Vt, LAS float* wsf, int r32, int hi, int lane, int qpos, int kpos0, bool first) {
    s16x8 kf[8];
#pragma unroll
    for (int d0 = 0; d0 < 4; ++d0) { const int c = 2 * d0 + hi; LAS const unsigned char* kp = Kt + BOFF + c * 1024 + ((r32 ^ c) << 4);
        kf[2 * d0] = *(LAS const s16x8*)kp; kf[2 * d0 + 1] = *(LAS const s16x8*)(kp + 512); }
    LAS const unsigned char* vbp = Vt + BOFF + ((lane >> 4) & 1) * 32 + (lane & 3) * 8 + (4 * hi + ((lane & 15) >> 2)) * 64;
    s16x4 va[8], vb[8];
#pragma unroll
    for (int bl_ = 0; bl_ < NBLK; ++bl_) { va[2 * bl_] = vtr(vbp + bl_ * 4096); va[2 * bl_ + 1] = vtr(vbp + bl_ * 4096 + 512); }
    __builtin_amdgcn_sched_barrier(0);
    f32x16 p0, p1;
    p0 = __builtin_amdgcn_mfma_f32_32x32x16_bf16(kf[0], st.q[0], st.negm, 0, 0, 0);
    p1 = __builtin_amdgcn_mfma_f32_32x32x16_bf16(kf[1], st.q[0], st.negm, 0, 0, 0);
#pragma unroll
    for (int d0 = 1; d0 < 4; ++d0) {
        p0 = __builtin_amdgcn_mfma_f32_32x32x16_bf16(kf[2 * d0], st.q[d0], p0, 0, 0, 0);
        p1 = __builtin_amdgcn_mfma_f32_32x32x16_bf16(kf[2 * d0 + 1], st.q[d0], p1, 0, 0, 0);
    }
    if (MASK) {
        asm volatile("s_nop 15\n\ts_nop 7" : "+v"(p0), "+v"(p1));
#pragma unroll
        for (int r = 0; r < 16; ++r) { const int d = qpos - (kpos0 + crow(r, hi)); if (d > 128 || d < -128) p0[r] = -1.0e30f; const int d2 = d - 32; if (d2 > 128 || d2 < -128) p1[r] = -1.0e30f; }
    } else {
        asm volatile("s_nop 7" : "+v"(p0), "+v"(p1));
    }
    const float rm0_ = max16(p0); const float rm1_ = max16(p1);
    float rm = max2f(rm0_, rm1_);
    { const unsigned x_ = __float_as_uint(rm); auto rr_ = __builtin_amdgcn_permlane32_swap(x_, x_, false, false); rm = max2f(__uint_as_float(rr_[0]), __uint_as_float(rr_[1])); }
    if (first || __any(rm > 8.f)) {
        const float dl = first ? rm : fmaxf(rm, 0.f); const float alpha = __builtin_amdgcn_exp2f(-dl); st.m += dl; st.l *= alpha;
#pragma unroll
        for (int r = 0; r < 16; ++r) { p0[r] -= dl; p1[r] -= dl; st.negm[r] = -st.m; }
        if (hi == 0) wsf[r32] = alpha;
#pragma unroll
        for (int g = 0; g < 4; ++g) { const f32x4 a4 = *(LAS const f32x4*)(wsf + 8 * g + 4 * hi);
#pragma unroll
            for (int j = 0; j < 4; ++j)
#pragma unroll
                for (int blk = 0; blk < NBLK; ++blk) st.o[blk][4 * g + j] *= a4[j]; }
    }
    float sq0 = 0.f, sq1 = 0.f;
    u32x4 pw[4];
#define ATT_FILL(PV_, base, s, g) do { const float ea_ = __builtin_amdgcn_exp2f(PV_[(base) + 2 * (g)]), eb_ = __builtin_amdgcn_exp2f(PV_[(base) + 2 * (g) + 1]); \
        sq0 += ea_; sq1 += eb_; pw[s][g] = cvtpk(ea_, eb_); } while (0)
#define ATT_VREAD_KS(buf, ks) do { _Pragma("unroll") for (int bl_ = 0; bl_ < NBLK; ++bl_) { buf[2 * bl_] = vtr(vbp + bl_ * 4096 + (ks) * 1024); buf[2 * bl_ + 1] = vtr(vbp + bl_ * 4096 + (ks) * 1024 + 512); } } while (0)
#define ATT_MFMA1(buf, ks, bl_) do { const s16x4 lo_ = buf[2 * (bl_)], hh_ = buf[2 * (bl_) + 1]; \
        const s16x8 vf_ = {lo_[0], lo_[1], lo_[2], lo_[3], hh_[0], hh_[1], hh_[2], hh_[3]}; \
        st.o[bl_] = __builtin_amdgcn_mfma_f32_32x32x16_bf16(__builtin_bit_cast(s16x8, pw[ks]), vf_, st.o[bl_], 0, 0, 0); } while (0)
    ATT_FILL(p0, 0, 0, 0); ATT_FILL(p0, 0, 0, 1); ATT_FILL(p0, 0, 0, 2); ATT_FILL(p0, 0, 0, 3);
    __builtin_amdgcn_sched_barrier(0);
    ATT_VREAD_KS(vb, 1);
    __builtin_amdgcn_sched_barrier(0);
    if (NBLK == 4) {
        ATT_MFMA1(va, 0, 0); ATT_FILL(p0, 8, 1, 0); __builtin_amdgcn_sched_barrier(0);
        ATT_MFMA1(va, 0, 1); ATT_FILL(p0, 8, 1, 1); __builtin_amdgcn_sched_barrier(0);
        ATT_MFMA1(va, 0, 2); ATT_FILL(p0, 8, 1, 2); __builtin_amdgcn_sched_barrier(0);
        ATT_MFMA1(va, 0, 3); ATT_FILL(p0, 8, 1, 3); __builtin_amdgcn_sched_barrier(0);
        ATT_VREAD_KS(va, 2);
        __builtin_amdgcn_sched_barrier(0);
        ATT_MFMA1(vb, 1, 0); ATT_FILL(p1, 0, 2, 0); __builtin_amdgcn_sched_barrier(0);
        ATT_MFMA1(vb, 1, 1); ATT_FILL(p1, 0, 2, 1); __builtin_amdgcn_sched_barrier(0);
        ATT_MFMA1(vb, 1, 2); ATT_FILL(p1, 0, 2, 2); __builtin_amdgcn_sched_barrier(0);
        ATT_MFMA1(vb, 1, 3); ATT_FILL(p1, 0, 2, 3); __builtin_amdgcn_sched_barrier(0);
        ATT_VREAD_KS(vb, 3);
        __builtin_amdgcn_sched_barrier(0);
        ATT_MFMA1(va, 2, 0); ATT_FILL(p1, 8, 3, 0); __builtin_amdgcn_sched_barrier(0);
        ATT_MFMA1(va, 2, 1); ATT_FILL(p1, 8, 3, 1); __builtin_amdgcn_sched_barrier(0);
        ATT_MFMA1(va, 2, 2); ATT_FILL(p1, 8, 3, 2); __builtin_amdgcn_sched_barrier(0);
        ATT_MFMA1(va, 2, 3); ATT_FILL(p1, 8, 3, 3); __builtin_amdgcn_sched_barrier(0);
        ATT_MFMA1(vb, 3, 0); ATT_MFMA1(vb, 3, 1); ATT_MFMA1(vb, 3, 2); ATT_MFMA1(vb, 3, 3);
    } else {
        ATT_MFMA1(va, 0, 0); ATT_FILL(p0, 8, 1, 0); ATT_FILL(p0, 8, 1, 1); __builtin_amdgcn_sched_barrier(0);
        ATT_MFMA1(va, 0, 1); ATT_FILL(p0, 8, 1, 2); ATT_FILL(p0, 8, 1, 3); __builtin_amdgcn_sched_barrier(0);
        ATT_VREAD_KS(va, 2);
        __builtin_amdgcn_sched_barrier(0);
        ATT_MFMA1(vb, 1, 0); ATT_FILL(p1, 0, 2, 0); ATT_FILL(p1, 0, 2, 1); __builtin_amdgcn_sched_barrier(0);
        ATT_MFMA1(vb, 1, 1); ATT_FILL(p1, 0, 2, 2); ATT_FILL(p1, 0, 2, 3); __builtin_amdgcn_sched_barrier(0);
        ATT_VREAD_KS(vb, 3);
        __builtin_amdgcn_sched_barrier(0);
        ATT_MFMA1(va, 2, 0); ATT_FILL(p1, 8, 3, 0); ATT_FILL(p1, 8, 3, 1); __builtin_amdgcn_sched_barrier(0);
        ATT_MFMA1(va, 2, 1); ATT_FILL(p1, 8, 3, 2); ATT_FILL(p1, 8, 3, 3); __builtin_amdgcn_sched_barrier(0);
        ATT_MFMA1(vb, 3, 0); ATT_MFMA1(vb, 3, 1);
    }
    st.l += sq0 + sq1;
#undef ATT_FILL
#undef ATT_VREAD_KS
#undef ATT_MFMA1
}
__device__ __forceinline__ unsigned char f2fp8(float v) { return (unsigned char)(__builtin_amdgcn_cvt_pk_fp8_f32(v, 0.f, 0, false) & 0xff); }
typedef int att_v8i __attribute__((ext_vector_type(8)));
typedef int att_v2i __attribute__((ext_vector_type(2)));
__device__ __forceinline__ att_v2i vtr8(LAS const unsigned char* p) { return __builtin_amdgcn_ds_read_tr8_b64_v2i32((LAS att_v2i*)p); }
template <int NBLK, bool MASK, int BOFF, bool FIRST>
__device__ __forceinline__ void attn_fix8(RowSt<NBLK>& st, LAS const unsigned char* Kt, LAS float* wsf, int r32, int hi, int qpos, int kpos0) {
    u32x4 ka0, ka1, kb0, kb1;
    { const int c = 2 * hi; LAS const unsigned char* kp = Kt + BOFF + c * 1024 + ((r32 ^ c) << 4), *kq = Kt + BOFF + (c + 1) * 1024 + ((r32 ^ (c + 1)) << 4);
      ka0 = *(LAS const u32x4*)kp; kb0 = *(LAS const u32x4*)(kp + 512); ka1 = *(LAS const u32x4*)kq; kb1 = *(LAS const u32x4*)(kq + 512); }
    f32x16 p0, p1;
    {
        const att_v8i q8 = {(int)__builtin_bit_cast(u32x4, st.q[0]).x, (int)__builtin_bit_cast(u32x4, st.q[0]).y, (int)__builtin_bit_cast(u32x4, st.q[0]).z, (int)__builtin_bit_cast(u32x4, st.q[0]).w,
                            (int)__builtin_bit_cast(u32x4, st.q[1]).x, (int)__builtin_bit_cast(u32x4, st.q[1]).y, (int)__builtin_bit_cast(u32x4, st.q[1]).z, (int)__builtin_bit_cast(u32x4, st.q[1]).w};
        const att_v8i k0 = {(int)ka0.x, (int)ka0.y, (int)ka0.z, (int)ka0.w, (int)ka1.x, (int)ka1.y, (int)ka1.z, (int)ka1.w};
        const att_v8i k1 = {(int)kb0.x, (int)kb0.y, (int)kb0.z, (int)kb0.w, (int)kb1.x, (int)kb1.y, (int)kb1.z, (int)kb1.w};
        p0 = __builtin_amdgcn_mfma_scale_f32_32x32x64_f8f6f4(k0, q8, st.negm, 0, 0, 0, 0x7f7f7f7f, 0, 0x7c7c7c7c);
        p1 = __builtin_amdgcn_mfma_scale_f32_32x32x64_f8f6f4(k1, q8, st.negm, 0, 0, 0, 0x7f7f7f7f, 0, 0x7c7c7c7c);
    }
    asm volatile("s_nop 15\n\ts_nop 7" : "+v"(p0), "+v"(p1));
    if (MASK) {
#pragma unroll
        for (int r = 0; r < 16; ++r) { const int d = qpos - (kpos0 + crow(r, hi)); if (d > 128 || d < -128) p0[r] = -1.0e30f; const int d2 = d - 32; if (d2 > 128 || d2 < -128) p1[r] = -1.0e30f; }
    }
    const float rm0_ = max16(p0); const float rm1_ = max16(p1);
    float rm = max2f(rm0_, rm1_);
    { const unsigned x_ = __float_as_uint(rm); auto rr_ = __builtin_amdgcn_permlane32_swap(x_, x_, false, false); rm = max2f(__uint_as_float(rr_[0]), __uint_as_float(rr_[1])); }
    const float dl = FIRST ? rm : fmaxf(rm, 0.f); st.m += dl;
#pragma unroll
    for (int r = 0; r < 16; ++r) st.negm[r] = -st.m;
    if (!FIRST) {
        const float alpha = __builtin_amdgcn_exp2f(-dl); st.l2 *= alpha;
        if (hi == 0) wsf[r32] = alpha;
#pragma unroll
        for (int g = 0; g < 4; ++g) { const f32x4 a4 = *(LAS const f32x4*)(wsf + 8 * g + 4 * hi);
#pragma unroll
            for (int j = 0; j < 4; ++j)
#pragma unroll
                for (int blk = 0; blk < NBLK; ++blk) st.o[blk][4 * g + j] *= a4[j]; }
    }
}
template <int NBLK, bool MASK, int BOFF>
__device__ __forceinline__ void attn_tile8(RowSt<NBLK>& st, LAS const unsigned char* Kt, LAS const unsigned char* Vt, LAS float* wsf, int r32, int hi, int lane, int qpos, int kpos0) {
    u32x4 ka0, ka1, kb0, kb1;
    { const int c = 2 * hi; LAS const unsigned char* kp = Kt + BOFF + c * 1024 + ((r32 ^ c) << 4), *kq = Kt + BOFF + (c + 1) * 1024 + ((r32 ^ (c + 1)) << 4);
      ka0 = *(LAS const u32x4*)kp; kb0 = *(LAS const u32x4*)(kp + 512); ka1 = *(LAS const u32x4*)kq; kb1 = *(LAS const u32x4*)(kq + 512); }
    const int rho = (lane & 15) >> 1;
    constexpr int VR = 32 * NBLK;
    const int lkey = 4 * hi + (rho & 3) + 8 * (rho >> 2), sw = NBLK == 4 ? (((rho >> 1) & 1) | (((rho >> 2) & 1) << 1)) : ((rho >> 2) & 1);
    LAS const unsigned char* vb_ = Vt + BOFF + lkey * VR + 16 * ((lane >> 4) & 1) + 8 * (lane & 1);
    __builtin_amdgcn_sched_barrier(0);
    f32x16 p0, p1;
    {
        const att_v8i q8 = {(int)__builtin_bit_cast(u32x4, st.q[0]).x, (int)__builtin_bit_cast(u32x4, st.q[0]).y, (int)__builtin_bit_cast(u32x4, st.q[0]).z, (int)__builtin_bit_cast(u32x4, st.q[0]).w,
                            (int)__builtin_bit_cast(u32x4, st.q[1]).x, (int)__builtin_bit_cast(u32x4, st.q[1]).y, (int)__builtin_bit_cast(u32x4, st.q[1]).z, (int)__builtin_bit_cast(u32x4, st.q[1]).w};
        const att_v8i k0 = {(int)ka0.x, (int)ka0.y, (int)ka0.z, (int)ka0.w, (int)ka1.x, (int)ka1.y, (int)ka1.z, (int)ka1.w};
        const att_v8i k1 = {(int)kb0.x, (int)kb0.y, (int)kb0.z, (int)kb0.w, (int)kb1.x, (int)kb1.y, (int)kb1.z, (int)kb1.w};
        p0 = __builtin_amdgcn_mfma_scale_f32_32x32x64_f8f6f4(k0, q8, st.negm, 0, 0, 0, 0x7f7f7f7f, 0, 0x7c7c7c7c);
        p1 = __builtin_amdgcn_mfma_scale_f32_32x32x64_f8f6f4(k1, q8, st.negm, 0, 0, 0, 0x7f7f7f7f, 0, 0x7c7c7c7c);
    }
    __builtin_amdgcn_sched_barrier(0);
    att_v2i vf[NBLK][4];
#pragma unroll
    for (int blk = 0; blk < NBLK; ++blk)
#pragma unroll
        for (int q = 0; q < 4; ++q) vf[blk][q] = vtr8(vb_ + ((blk ^ sw) * 32) + (q & 1) * (16 * VR) + (q >> 1) * (32 * VR));
    __builtin_amdgcn_sched_barrier(0);
    if (MASK) {
        asm volatile("s_nop 15\n\ts_nop 7" : "+v"(p0), "+v"(p1));
#pragma unroll
        for (int r = 0; r < 16; ++r) { const int d = qpos - (kpos0 + crow(r, hi)); if (d > 128 || d < -128) p0[r] = -1.0e30f; const int d2 = d - 32; if (d2 > 128 || d2 < -128) p1[r] = -1.0e30f; }
    }
    att_v8i pa; att_f2 ts;
#define ATT_EXPS() do { \
        att_f2 ee[8], ff[8];                  \
        _Pragma("unroll") for (int d = 0; d < 4; ++d) { \
            ee[2 * d] = att_f2{__builtin_amdgcn_exp2f(p0[4 * d]), __builtin_amdgcn_exp2f(p0[4 * d + 1])}; ee[2 * d + 1] = att_f2{__builtin_amdgcn_exp2f(p0[4 * d + 2]), __builtin_amdgcn_exp2f(p0[4 * d + 3])}; \
            ff[2 * d] = att_f2{__builtin_amdgcn_exp2f(p1[4 * d]), __builtin_amdgcn_exp2f(p1[4 * d + 1])}; ff[2 * d + 1] = att_f2{__builtin_amdgcn_exp2f(p1[4 * d + 2]), __builtin_amdgcn_exp2f(p1[4 * d + 3])}; } \
        _Pragma("unroll") for (int d = 0; d < 4; ++d) { \
            int wa, wb; asm volatile("" : "=v"(wa), "=v"(wb));         \
            wa = __builtin_amdgcn_cvt_pk_fp8_f32(ee[2 * d].x, ee[2 * d].y, wa, false); wa = __builtin_amdgcn_cvt_pk_fp8_f32(ee[2 * d + 1].x, ee[2 * d + 1].y, wa, true); \
            wb = __builtin_amdgcn_cvt_pk_fp8_f32(ff[2 * d].x, ff[2 * d].y, wb, false); wb = __builtin_amdgcn_cvt_pk_fp8_f32(ff[2 * d + 1].x, ff[2 * d + 1].y, wb, true); \
            pa[d] = wa; pa[4 + d] = wb; } \
        att_f2 sa = ee[0] + ee[1], sb = ff[0] + ff[1]; \
        _Pragma("unroll") for (int d = 2; d < 8; ++d) { sa += ee[d]; sb += ff[d]; } \
        ts = sa + sb; } while (0)
    ATT_EXPS();
    if (__any(!(ts.x + ts.y <= 256.f))) {
        { const int c = 2 * hi; LAS const unsigned char* kp = Kt + BOFF + c * 1024 + ((r32 ^ c) << 4), *kq = Kt + BOFF + (c + 1) * 1024 + ((r32 ^ (c + 1)) << 4);
          ka0 = *(LAS const u32x4*)kp; kb0 = *(LAS const u32x4*)(kp + 512); ka1 = *(LAS const u32x4*)kq; kb1 = *(LAS const u32x4*)(kq + 512); }
        {
            const att_v8i q8 = {(int)__builtin_bit_cast(u32x4, st.q[0]).x, (int)__builtin_bit_cast(u32x4, st.q[0]).y, (int)__builtin_bit_cast(u32x4, st.q[0]).z, (int)__builtin_bit_cast(u32x4, st.q[0]).w,
                                (int)__builtin_bit_cast(u32x4, st.q[1]).x, (int)__builtin_bit_cast(u32x4, st.q[1]).y, (int)__builtin_bit_cast(u32x4, st.q[1]).z, (int)__builtin_bit_cast(u32x4, st.q[1]).w};
            const att_v8i k0 = {(int)ka0.x, (int)ka0.y, (int)ka0.z, (int)ka0.w, (int)ka1.x, (int)ka1.y, (int)ka1.z, (int)ka1.w};
            const att_v8i k1 = {(int)kb0.x, (int)kb0.y, (int)kb0.z, (int)kb0.w, (int)kb1.x, (int)kb1.y, (int)kb1.z, (int)kb1.w};
            p0 = __builtin_amdgcn_mfma_scale_f32_32x32x64_f8f6f4(k0, q8, st.negm, 0, 0, 0, 0x7f7f7f7f, 0, 0x7c7c7c7c);
            p1 = __builtin_amdgcn_mfma_scale_f32_32x32x64_f8f6f4(k1, q8, st.negm, 0, 0, 0, 0x7f7f7f7f, 0, 0x7c7c7c7c);
        }
        asm volatile("s_nop 15\n\ts_nop 7" : "+v"(p0), "+v"(p1));
        if (MASK) {
#pragma unroll
            for (int r = 0; r < 16; ++r) { const int d = qpos - (kpos0 + crow(r, hi)); if (d > 128 || d < -128) p0[r] = -1.0e30f; const int d2 = d - 32; if (d2 > 128 || d2 < -128) p1[r] = -1.0e30f; }
        }
        const float rm0_ = max16(p0); const float rm1_ = max16(p1);
        float rm = max2f(rm0_, rm1_);
        { const unsigned x_ = __float_as_uint(rm); auto rr_ = __builtin_amdgcn_permlane32_swap(x_, x_, false, false); rm = max2f(__uint_as_float(rr_[0]), __uint_as_float(rr_[1])); }
        const float dl = fmaxf(rm, 0.f); const float alpha = __builtin_amdgcn_exp2f(-dl); st.m += dl; st.l2 *= alpha;
#pragma unroll
        for (int r = 0; r < 16; ++r) { p0[r] -= dl; p1[r] -= dl; st.negm[r] = -st.m; }
        if (hi == 0) wsf[r32] = alpha;
#pragma unroll
        for (int g = 0; g < 4; ++g) { const f32x4 a4 = *(LAS const f32x4*)(wsf + 8 * g + 4 * hi);
#pragma unroll
            for (int j = 0; j < 4; ++j)
#pragma unroll
                for (int blk = 0; blk < NBLK; ++blk) st.o[blk][4 * g + j] *= a4[j]; }
        ATT_EXPS();
    }
#undef ATT_EXPS
    st.l2 += ts;
    asm volatile("" : "+v"(pa), "+v"(st.l2));
#pragma unroll
    for (int blk = 0; blk < NBLK; ++blk) {
        const att_v8i vb8 = {vf[blk][0].x, vf[blk][0].y, vf[blk][1].x, vf[blk][1].y, vf[blk][2].x, vf[blk][2].y, vf[blk][3].x, vf[blk][3].y};
        st.o[blk] = __builtin_amdgcn_mfma_scale_f32_32x32x64_f8f6f4(pa, vb8, st.o[blk], 0, 0, 0, 0x7f7f7f7f, 0, 0x7f7f7f7f);
    }
}
template <int NBLK>
__device__ __forceinline__ void attn_finish(RowSt<NBLK>& st, LAS float* wsf, int r32, int hi) {
    const float ll_ = st.l2.x + st.l2.y; const float lt = ll_ + xchg32(ll_);
    if (hi == 0) wsf[r32] = 1.f / lt;
#pragma unroll
    for (int g = 0; g < 4; ++g) { const f32x4 a4 = *(LAS const f32x4*)(wsf + 8 * g + 4 * hi);
#pragma unroll
        for (int j = 0; j < 4; ++j)
#pragma unroll
            for (int blk = 0; blk < NBLK; ++blk) st.o[blk][4 * g + j] *= a4[j]; }
}
template <int CTRL> __device__ __forceinline__ float att_dpp(float v) { return __int_as_float(__builtin_amdgcn_update_dpp(0, __float_as_int(v), CTRL, 0xf, 0xf, true)); }
__device__ __forceinline__ float half_sum32(float v) {
    v += att_dpp<0xB1>(v); v += att_dpp<0x4E>(v); v += att_dpp<0x141>(v); v += att_dpp<0x140>(v);
    auto r_ = __builtin_amdgcn_permlane16_swap(__float_as_uint(v), __float_as_uint(v), false, false);
    return __uint_as_float(r_[0]) + __uint_as_float(r_[1]);
}

__device__ __forceinline__ void diff_unit(const unsigned char* __restrict__ Q8, const unsigned char* __restrict__ K8, const unsigned char* __restrict__ V8, const float* __restrict__ diff_norm, float lam, bf16* __restrict__ AO, LAS unsigned char* lds, int b, int h, int qb, int tid, int wave, int lane) {
    const int r32 = lane & 31, hi = lane >> 5, map = wave >> 2, rg = (wave & 3) * 32;
    LAS float* wsf = (LAS float*)(lds + RING_BYTES) + wave * 64;
    LAS float* X = (LAS float*)(lds + 65536);
    RowSt<4> st;
    { const unsigned char* qp = Q8 + (size_t)(b * S + qb * 128 + rg + r32) * 1024 + h * 128 + map * 64 + hi * 32;
      st.q[0] = *(const s16x8*)qp; st.q[1] = *(const s16x8*)(qp + 16); }
#pragma unroll
    for (int blk = 0; blk < 4; ++blk)
#pragma unroll
        for (int r = 0; r < 16; ++r) st.o[blk][r] = 0.f;
    st.m = 0.f; st.l2 = att_f2{0.f, 0.f};
#pragma unroll
    for (int r = 0; r < 16; ++r) st.negm[r] = 0.f;
    const int kr = tid >> 3, kc = tid & 7;
    const unsigned koff = (kc >> 2) * 4096 + (kc & 3) * 1024 + ((kr ^ (kc & 3)) << 4);
    const int NT = (CL + S) / 64;
    u32x4 gk1, gv0, gk2, gv1;
    const unsigned voff = kr * 128 + ((((unsigned)kc >> 1) ^ ((((unsigned)kr >> 1) & 1u) | ((((unsigned)kr >> 3) & 1u) << 1))) * 32) + (kc & 1) * 16;
#define DROWBASE(t) ((t) < 4 ? (size_t)(M + b * CL + (t) * 64) : (size_t)(b * S + ((t) - 4) * 64))
    const unsigned vgo = (unsigned)(kr * 1024 + kc * 16);
    const __amdgpu_buffer_rsrc_t rK = __builtin_amdgcn_make_buffer_rsrc((void*)K8, 0, 0x7fffffff, 0x00020000), rV = __builtin_amdgcn_make_buffer_rsrc((void*)V8, 0, 0x7fffffff, 0x00020000);
#define gload2(t) do { const int rb_ = (int)(DROWBASE(t) * 1024 + h * 128), rc_ = (int)(DROWBASE((t) + 1) * 1024 + h * 128); \
        gk1 = __builtin_amdgcn_raw_buffer_load_b128(rK, (int)vgo, rb_, 0); gv0 = __builtin_amdgcn_raw_buffer_load_b128(rV, (int)vgo, rb_, 0); \
        gk2 = __builtin_amdgcn_raw_buffer_load_b128(rK, (int)vgo, rc_, 0); gv1 = __builtin_amdgcn_raw_buffer_load_b128(rV, (int)vgo, rc_, 0); } while (0)
#define lwrite2(buf) do { LAS unsigned char* bp_ = lds + (buf) * 32768; *(LAS u32x4*)(bp_ + koff) = gk1; *(LAS u32x4*)(bp_ + 16384 + voff) = gv0; \
        *(LAS u32x4*)(bp_ + 32768 + koff) = gk2; *(LAS u32x4*)(bp_ + 32768 + 16384 + voff) = gv1; } while (0)
    gload2(0); lwrite2(0);
    __syncthreads();
    LAS const unsigned char* kbase = lds + map * 4096;
    attn_fix8<4, false, 0, true>(st, kbase, wsf, r32, hi, 0, 0);
    static_assert(((CL + S) / 64) % 4 == 0, "tile pairs");
#pragma unroll 1
    for (int t = 0; t < NT; t += 4) {
        gload2(t + 2);
        attn_tile8<4, false, 0>(st, kbase, lds + 16384, wsf, r32, hi, lane, 0, 0);
        attn_tile8<4, false, 32768>(st, kbase, lds + 16384, wsf, r32, hi, lane, 0, 0);
        lwrite2(2);
        __syncthreads();
        if (t + 4 < NT) gload2(t + 4);
        attn_tile8<4, false, 65536>(st, kbase, lds + 16384, wsf, r32, hi, lane, 0, 0);
        attn_tile8<4, false, 98304>(st, kbase, lds + 16384, wsf, r32, hi, lane, 0, 0);
        if (t + 4 < NT) lwrite2(0);
        __syncthreads();
    }
    attn_finish<4>(st, wsf, r32, hi);
    if (map == 1) {
#pragma unroll
        for (int blk = 0; blk < 4; ++blk)
#pragma unroll
            for (int r = 0; r < 16; ++r) X[(((wave & 3) * 4 + blk) * 16 + r) * 64 + lane] = st.o[blk][r] * lam;
    }
    __syncthreads();
    if (map == 0) {
        const float gn0 = diff_norm[h * 128 + r32], gn1 = diff_norm[h * 128 + 32 + r32], gn2 = diff_norm[h * 128 + 64 + r32], gn3 = diff_norm[h * 128 + 96 + r32];
        LAS const float* Xw = X + (wave & 3) * 4096 + lane;
#pragma unroll
        for (int r = 0; r < 16; ++r) {
            const float v0 = st.o[0][r] - Xw[(0 * 16 + r) * 64], v1 = st.o[1][r] - Xw[(1 * 16 + r) * 64], v2 = st.o[2][r] - Xw[(2 * 16 + r) * 64], v3 = st.o[3][r] - Xw[(3 * 16 + r) * 64];
            const float rinv = rsqrtf(half_sum32((v0 * v0 + v1 * v1) + (v2 * v2 + v3 * v3)) * (1.f / 128.f) + EPS) * 0.8f;
            unsigned char* op = (unsigned char*)AO + (size_t)(b * S + qb * 128 + rg + crow(r, hi)) * D + h * 128 + r32;
            op[0] = f2fp8(v0 * rinv * gn0); op[32] = f2fp8(v1 * rinv * gn1); op[64] = f2fp8(v2 * rinv * gn2); op[96] = f2fp8(v3 * rinv * gn3);
        }
    }
}
#undef gload2
#undef lwrite2
#undef DROWBASE
__device__ __forceinline__ void swa_unit(const unsigned char* __restrict__ SQ8, const unsigned char* __restrict__ SK8, const unsigned char* __restrict__ SV8, const float* __restrict__ sink, const float* __restrict__ swa_norm, bf16* __restrict__ AO, LAS unsigned char* lds, int b, int kvh, int hb, int tid, int wave, int lane) {
    const int r32 = lane & 31, hi = lane >> 5, head = kvh * 4 + (wave >> 1), rbase = hb * 64 + (wave & 1) * 32;
    LAS float* wsf = (LAS float*)(lds + RING_BYTES) + wave * 64;
    RowSt<2> st;
    {
        const unsigned char* qp = SQ8 + (size_t)(b * S + rbase + r32) * 1024 + head * 64 + hi * 32;
        st.q[0] = *(const s16x8*)qp; st.q[1] = *(const s16x8*)(qp + 16);
#pragma unroll
        for (int blk = 0; blk < 2; ++blk)
#pragma unroll
            for (int r = 0; r < 16; ++r) st.o[blk][r] = 0.f;
        st.m = sink[head] * 1.4426950408889634f; st.l2 = att_f2{hi == 0 ? 1.f : 0.f, 0.f};
#pragma unroll
        for (int r = 0; r < 16; ++r) st.negm[r] = -st.m;
    }
    const int kr = (tid & 255) >> 2, kc = tid & 3; const bool isv = tid >= 256;
    const unsigned koff = isv ? 8192u + kr * 64 + (((unsigned)(kc >> 1) ^ (((unsigned)kr >> 3) & 1u)) * 32) + (kc & 1) * 16 : (unsigned)(kc * 1024 + ((kr ^ kc) << 4));
    const int klo = hb - 2 < 0 ? 0 : hb - 2, khi = hb + 2 > S / 64 - 1 ? S / 64 - 1 : hb + 2;
    const int NT = 4 + (khi - klo + 1);
    u32x4 gk;
    const unsigned char* const src8 = isv ? SV8 : SK8;
#define SROWBASE(t) ((t) < 4 ? (size_t)(M + b * CL + (t) * 64) : (size_t)(b * S + (klo + (t) - 4) * 64))
#define gload(t) do { gk = *(const u32x4*)(src8 + (SROWBASE(t) + kr) * 256 + kvh * 64 + kc * 16); } while (0)
#define lwrite(buf) do { *(LAS u32x4*)(lds + (buf) * 16384 + koff) = gk; } while (0)
    gload(0); lwrite(0);
    __syncthreads();
    const int qpos = rbase + r32;
#define SWA_STEP(t_, BO, nb) do { if ((t_) + 1 < NT) gload((t_) + 1); \
        if ((t_) < 4 || (klo + (t_) - 4 != hb - 2 && klo + (t_) - 4 != hb + 2)) attn_tile8<2, false, BO>(st, lds, lds + 8192, wsf, r32, hi, lane, 0, 0);        \
        else attn_tile8<2, true, BO>(st, lds, lds + 8192, wsf, r32, hi, lane, qpos, (klo + (t_) - 4) * 64); \
        if ((t_) + 1 < NT) lwrite(nb); \
        __syncthreads(); } while (0)
    int t = 0;
#pragma unroll 1
    for (; t + 1 < NT; t += 2) { SWA_STEP(t, 0, 1); SWA_STEP(t + 1, 16384, 0); }
    if (t < NT) SWA_STEP(t, 0, 1);
#undef SWA_STEP
#undef gload
#undef lwrite
#undef SROWBASE
    const float gn0 = swa_norm[head * 64 + r32], gn1 = swa_norm[head * 64 + 32 + r32];
    attn_finish<2>(st, wsf, r32, hi);
#pragma unroll
    for (int r = 0; r < 16; ++r) {
        const float v0 = st.o[0][r], v1 = st.o[1][r];
        const float rinv = rsqrtf(half_sum32(v0 * v0 + v1 * v1) * (1.f / 64.f) + EPS);
        unsigned char* op = (unsigned char*)AO + (size_t)(b * S + rbase + crow(r, hi)) * D + 1024 + head * 64 + r32;
        op[0] = f2fp8(v0 * rinv * gn0); op[32] = f2fp8(v1 * rinv * gn1);
    }
}
__device__ __forceinline__ void attn_phase(const Args& a, LAS unsigned char* lds, int bx, int G, int tid, int wave, int lane) {
    const bf16* P = (const bf16*)(a.ws + WS_P); bf16* AO = (bf16*)(a.ws + WS_AO);
    const float s1 = wave_sum(a.in[8][lane] * a.in[9][lane]), s2 = wave_sum(a.in[10][lane] * a.in[11][lane]);
    const float lam = __expf(s1) - __expf(s2) + 0.2f;
    for (int L = bx; L < 1024; L += G) { const int bh = (L & 7) + 8 * (L >> 8), qb = (L >> 3) & 31; diff_unit(a.ws + WS_Q8, a.ws + WS_K8, a.ws + WS_V8, a.in[12], lam, AO, lds, bh >> 3, bh & 7, qb, tid, wave, lane); }
    for (int L = bx; L < 1024; L += G) { const int bk = (L & 7) + 8 * (L >> 9), hb = (L >> 3) & 63; swa_unit(a.ws + WS_SQ8, a.ws + WS_SK8, a.ws + WS_SV8, a.in[13], a.in[14], AO, lds, bk >> 2, bk & 3, hb, tid, wave, lane); }
}


typedef __bf16 bf16x2_t __attribute__((ext_vector_type(2)));
typedef unsigned v16u __attribute__((ext_vector_type(16)));
__device__ __forceinline__ float dot2bf(unsigned a, unsigned b, float c) { return __builtin_amdgcn_fdot2_f32_bf16(__builtin_bit_cast(bf16x2_t, a), __builtin_bit_cast(bf16x2_t, b), c, false); }
template <int CTRL> __device__ __forceinline__ float dppf(float v) { return __int_as_float(__builtin_amdgcn_update_dpp(0, __float_as_int(v), CTRL, 0xf, 0xf, true)); }
__device__ __forceinline__ float med3(float a, float b, float c) { return __builtin_amdgcn_fmed3f(a, b, c); }
#define TK_INSERT(L, v) do { const float v_ = (v); \
    L[15] = med3(L[14], L[15], v_); L[14] = med3(L[13], L[14], v_); L[13] = med3(L[12], L[13], v_); L[12] = med3(L[11], L[12], v_); \
    L[11] = med3(L[10], L[11], v_); L[10] = med3(L[9], L[10], v_); L[9] = med3(L[8], L[9], v_); L[8] = med3(L[7], L[8], v_); \
    L[7] = med3(L[6], L[7], v_); L[6] = med3(L[5], L[6], v_); L[5] = med3(L[4], L[5], v_); L[4] = med3(L[3], L[4], v_); \
    L[3] = med3(L[2], L[3], v_); L[2] = med3(L[1], L[2], v_); L[1] = med3(L[0], L[1], v_); L[0] = fmaxf(L[0], v_); } while (0)
#define TK_CE(L, a_, b_) do { const float hi_ = fmaxf(L[a_], L[b_]), lo_ = fminf(L[a_], L[b_]); L[a_] = hi_; L[b_] = lo_; } while (0)
#define TK_MERGE(L) do { \
    const float p0_ = xchg32(L[0]), p1_ = xchg32(L[1]), p2_ = xchg32(L[2]), p3_ = xchg32(L[3]), p4_ = xchg32(L[4]), p5_ = xchg32(L[5]), p6_ = xchg32(L[6]), p7_ = xchg32(L[7]); \
    const float p8_ = xchg32(L[8]), p9_ = xchg32(L[9]), p10_ = xchg32(L[10]), p11_ = xchg32(L[11]), p12_ = xchg32(L[12]), p13_ = xchg32(L[13]), p14_ = xchg32(L[14]), p15_ = xchg32(L[15]); \
    L[0] = fmaxf(L[0], p15_); L[1] = fmaxf(L[1], p14_); L[2] = fmaxf(L[2], p13_); L[3] = fmaxf(L[3], p12_); L[4] = fmaxf(L[4], p11_); L[5] = fmaxf(L[5], p10_); L[6] = fmaxf(L[6], p9_); L[7] = fmaxf(L[7], p8_); \
    L[8] = fmaxf(L[8], p7_); L[9] = fmaxf(L[9], p6_); L[10] = fmaxf(L[10], p5_); L[11] = fmaxf(L[11], p4_); L[12] = fmaxf(L[12], p3_); L[13] = fmaxf(L[13], p2_); L[14] = fmaxf(L[14], p1_); L[15] = fmaxf(L[15], p0_); \
    TK_CE(L, 0, 8); TK_CE(L, 1, 9); TK_CE(L, 2, 10); TK_CE(L, 3, 11); TK_CE(L, 4, 12); TK_CE(L, 5, 13); TK_CE(L, 6, 14); TK_CE(L, 7, 15); \
    TK_CE(L, 0, 4); TK_CE(L, 1, 5); TK_CE(L, 2, 6); TK_CE(L, 3, 7); TK_CE(L, 8, 12); TK_CE(L, 9, 13); TK_CE(L, 10, 14); TK_CE(L, 11, 15); \
    TK_CE(L, 0, 2); TK_CE(L, 1, 3); TK_CE(L, 4, 6); TK_CE(L, 5, 7); TK_CE(L, 8, 10); TK_CE(L, 9, 11); TK_CE(L, 12, 14); TK_CE(L, 13, 15); \
    TK_CE(L, 0, 1); TK_CE(L, 2, 3); TK_CE(L, 4, 5); TK_CE(L, 6, 7); TK_CE(L, 8, 9); TK_CE(L, 10, 11); TK_CE(L, 12, 13); TK_CE(L, 14, 15); } while (0)

__device__ __forceinline__ void topk_half(float (&L)[16], const bf16* __restrict__ qp, LAS const unsigned char* skl, int r32, int hi) {
    s16x8 qf[8];
#pragma unroll
    for (int d0 = 0; d0 < 8; ++d0) qf[d0] = *(const s16x8*)(qp + d0 * 16);
#pragma unroll
    for (int j = 0; j < 16; ++j) L[j] = -3.0e38f;
#pragma unroll
    for (int kt = 0; kt < 4; ++kt) {
        f32x16 c;
#pragma unroll
        for (int r = 0; r < 16; ++r) c[r] = 0.f;
#pragma unroll
        for (int d0 = 0; d0 < 8; ++d0) { const int ch = 2 * d0 + hi;
            const s16x8 kf = *(LAS const s16x8*)(skl + ch * 2048 + (((kt * 32 + r32) ^ (ch & 7)) << 4));
            c = __builtin_amdgcn_mfma_f32_32x32x16_bf16(kf, qf[d0], c, 0, 0, 0); }
#pragma unroll
        for (int r = 0; r < 16; ++r) { const unsigned key = (unsigned)(kt * 32 + (r & 3) + 8 * (r >> 2)) | ((unsigned)hi << 2);
            const float pv = __uint_as_float((__float_as_uint(c[r]) & 0xFFFFFF80u) | key); TK_INSERT(L, pv); }
    }
    TK_MERGE(L);
}
__device__ __forceinline__ void topk_item(const bf16* __restrict__ Qp, const bf16* __restrict__ SK, int* __restrict__ IDX, float* __restrict__ G, LAS unsigned char* lds, int h, int tt, int tid, int wave, int lane) {
    const int r32 = lane & 31, hi = lane >> 5;
#pragma unroll
    for (int k = 0; k < 8; ++k) { const int e = tid + 512 * k; const int i = e >> 11, key = (e >> 4) & 127, c = e & 15;
        const u32x4 v = *(const u32x4*)(SK + ((size_t)(h * 2 + i) * 128 + key) * 128 + c * 8);
        *(LAS u32x4*)(lds + i * 32768 + c * 2048 + ((key ^ (c & 7)) << 4)) = v; }
    __syncthreads();
    const int t0 = tt * 256 + wave * 32;
    float s1[16], s2[16];
    topk_half(s1, Qp + (size_t)(t0 + r32) * D + h * 256 + hi * 8, lds, r32, hi);
    topk_half(s2, Qp + (size_t)(t0 + r32) * D + h * 256 + 128 + hi * 8, lds + 32768, r32, hi);
    float T[16];
#pragma unroll
    for (int j = 0; j < 16; ++j) T[j] = -3.0e38f;
#define TK_CAND(aa, bb) do { const float sm_ = s1[aa] + s2[bb]; TK_INSERT(T, __uint_as_float((__float_as_uint(sm_) & 0xFFFFFF00u) | (unsigned)((aa) * 16 + (bb)))); } while (0)
    TK_CAND(0, 0); TK_CAND(0, 1); TK_CAND(0, 2); TK_CAND(0, 3); TK_CAND(0, 4); TK_CAND(0, 5); TK_CAND(0, 6); TK_CAND(0, 7);
    TK_CAND(0, 8); TK_CAND(0, 9); TK_CAND(0, 10); TK_CAND(0, 11); TK_CAND(0, 12); TK_CAND(0, 13); TK_CAND(0, 14); TK_CAND(0, 15);
    TK_CAND(1, 0); TK_CAND(1, 1); TK_CAND(1, 2); TK_CAND(1, 3); TK_CAND(1, 4); TK_CAND(1, 5); TK_CAND(1, 6); TK_CAND(1, 7);
    TK_CAND(2, 0); TK_CAND(2, 1); TK_CAND(2, 2); TK_CAND(2, 3); TK_CAND(2, 4); TK_CAND(3, 0); TK_CAND(3, 1); TK_CAND(3, 2);
    TK_CAND(3, 3); TK_CAND(4, 0); TK_CAND(4, 1); TK_CAND(4, 2); TK_CAND(5, 0); TK_CAND(5, 1); TK_CAND(6, 0); TK_CAND(6, 1);
    TK_CAND(7, 0); TK_CAND(7, 1); TK_CAND(8, 0); TK_CAND(9, 0); TK_CAND(10, 0); TK_CAND(11, 0); TK_CAND(12, 0); TK_CAND(13, 0);
    TK_CAND(14, 0); TK_CAND(15, 0);
#undef TK_CAND
    LAS unsigned* tab = (LAS unsigned*)(lds + 65536) + wave * (32 * 33);
    if (hi == 0) {
#pragma unroll
        for (int j = 0; j < 16; ++j) { tab[r32 * 33 + j] = __float_as_uint(s1[j]) & 0x7Fu; tab[r32 * 33 + 16 + j] = __float_as_uint(s2[j]) & 0x7Fu; }
    }
    float mx = T[0], ev[16], sum = 0.f;
#pragma unroll
    for (int j = 0; j < 16; ++j) { ev[j] = __expf(T[j] - mx); sum += ev[j]; }
    const float inv = 1.f / sum;
    int* ip = IDX + (size_t)(t0 + r32) * 128 + h * 16; float* gp = G + (size_t)(t0 + r32) * 128 + h * 16;
    unsigned oi[16]; float og[16];
#pragma unroll
    for (int j = 0; j < 16; ++j) { const unsigned pc = __float_as_uint(T[j]) & 0xFFu; const unsigned k1 = tab[r32 * 33 + (pc >> 4)], k2 = tab[r32 * 33 + 16 + (pc & 15u)];
        oi[j] = k1 * 128u + k2; og[j] = ev[j] * inv; }
    if (hi == 0) {
        *(u32x4*)ip = (u32x4){oi[0], oi[1], oi[2], oi[3]}; *(u32x4*)(ip + 4) = (u32x4){oi[4], oi[5], oi[6], oi[7]};
        *(f32x4*)gp = (f32x4){og[0], og[1], og[2], og[3]}; *(f32x4*)(gp + 4) = (f32x4){og[4], og[5], og[6], og[7]};
    } else {
        *(u32x4*)(ip + 8) = (u32x4){oi[8], oi[9], oi[10], oi[11]}; *(u32x4*)(ip + 12) = (u32x4){oi[12], oi[13], oi[14], oi[15]};
        *(f32x4*)(gp + 8) = (f32x4){og[8], og[9], og[10], og[11]}; *(f32x4*)(gp + 12) = (f32x4){og[12], og[13], og[14], og[15]};
    }
    __syncthreads();
}
__device__ __forceinline__ void topk_phase(const Args& a, LAS unsigned char* lds, int bx, int G, int tid, int wave, int lane) {
    const bf16* Qp = (const bf16*)(a.ws + WS_QP); const bf16* SK = (const bf16*)(a.ws + WS_SK);
    int* IDX = (int*)(a.ws + WS_IDX); float* Gt = (float*)(a.ws + WS_G);
    pg8::StaticOrder S; S.init(M, D, G, bx);
    pg8::Unit u;
    for (int i = 0; S.next(i, u); ++i) topk_item(Qp, SK, IDX, Gt, lds, u.pn, u.pm, tid, wave, lane);
}

__device__ __forceinline__ float gelu_tanh_f(float x) { const float e = __builtin_amdgcn_exp2f(x * (2.3022082f + 0.10294324f * (x * x))); const float r = __builtin_amdgcn_rcpf(e + 1.f); return x - x * r; }
#define P8_LOAD(buf, scl, TAB, SCT, e0_) P8_LOADX(buf, e0_, id0, id1)
#define P8_LOADX(buf, e0_, I0_, I1_) do { _Pragma("unroll") for (int q_ = 0; q_ < 8; ++q_) { const int e_ = (e0_) + q_; const int idx_ = __builtin_amdgcn_readlane(e_ < 64 ? I0_ : I1_, e_ & 63); \
        const int so_ = idx_ * 1536; buf##A[q_] = __builtin_amdgcn_raw_buffer_load_b128(rU, lo16, so_, 0); buf##B[q_] = __builtin_amdgcn_raw_buffer_load_b64(rU, lo8, so_, 0); } } while (0)
#define P8_DEC(buf, q_) __builtin_amdgcn_cvt_scalef32_pk32_f32_fp6((v6u){buf##A[q_].x, buf##A[q_].y, buf##A[q_].z, buf##A[q_].w, buf##B[q_].x, buf##B[q_].y}, 1.0f)
#define P8_UGROUP(buf, scl, e0_) do { float d_[8]; \
        _Pragma("unroll") for (int q_ = 0; q_ < 8; ++q_) { const v16u r_ = __builtin_bit_cast(v16u, __builtin_amdgcn_cvt_scalef32_pk32_bf16_fp6((v6u){buf##A[q_].x, buf##A[q_].y, buf##A[q_].z, buf##A[q_].w, buf##B[q_].x, buf##B[q_].y}, 1.0f)); float s0_ = 0.f, s1_ = 0.f; \
            _Pragma("unroll") for (int i_ = 0; i_ < 16; i_ += 2) { s0_ = dot2bf(r_[i_], hvp[i_], s0_); s1_ = dot2bf(r_[i_ + 1], hvp[i_ + 1], s1_); } d_[q_] = s0_ + s1_; __builtin_amdgcn_sched_barrier(0); } \
        float d4_[4], d2_[2]; \
          \
        _Pragma("unroll") for (int q_ = 0; q_ < 4; ++q_) { auto r_ = __builtin_amdgcn_permlane32_swap(__float_as_uint(d_[q_]), __float_as_uint(d_[q_ + 4]), false, false); d4_[q_] = __uint_as_float(r_[0]) + __uint_as_float(r_[1]); } \
        _Pragma("unroll") for (int q_ = 0; q_ < 2; ++q_) { auto r_ = __builtin_amdgcn_permlane16_swap(__float_as_uint(d4_[q_]), __float_as_uint(d4_[q_ + 2]), false, false); d2_[q_] = __uint_as_float(r_[0]) + __uint_as_float(r_[1]); } \
        float d1_ = (b3 ? d2_[1] : d2_[0]) + dppf<0x128>(b3 ? d2_[0] : d2_[1]);         \
        d1_ += dppf<0xB1>(d1_); d1_ += dppf<0x4E>(d1_); d1_ += dppf<0x141>(d1_);        \
        const float raw_ = __shfl(d1_, ((lane - (e0_)) & 7) * 8);         \
        const float act_ = gelu_tanh_f(raw_ * ((e0_) < 64 ? su0 : su1)); \
        if ((e0_) < 64) { if ((unsigned)(lane - (e0_)) < 8u) w0 = g0 * act_; } else { if ((unsigned)(lane - ((e0_) - 64)) < 8u) w1 = g1 * act_; } } while (0)
typedef float f32x2 __attribute__((ext_vector_type(2)));
#define P8_VLOAD(buf, scl, e0_) do { _Pragma("unroll") for (int q_ = 0; q_ < 8; ++q_) { const int e_ = (e0_) + q_; const int idx_ = __builtin_amdgcn_readlane(e_ < 64 ? id0 : id1, e_ & 63); \
        buf[q_] = __builtin_amdgcn_raw_buffer_load_b128(rV, lo16, idx_ * 1024, 0); } } while (0)
#define P8_VGROUP(buf, scl, e0_) do { _Pragma("unroll") for (int q_ = 0; q_ < 8; ++q_) { const int e_ = (e0_) + q_; \
        const float wq_ = __int_as_float(__builtin_amdgcn_readlane(__float_as_int(e_ < 64 ? w0 : w1), e_ & 63)); \
        acc2[0] += __builtin_amdgcn_cvt_scalef32_pk_f32_fp4(buf[q_][0], 1.0f, 0) * wq_; acc2[1] += __builtin_amdgcn_cvt_scalef32_pk_f32_fp4(buf[q_][0], 1.0f, 1) * wq_; \
        acc2[2] += __builtin_amdgcn_cvt_scalef32_pk_f32_fp4(buf[q_][0], 1.0f, 2) * wq_; acc2[3] += __builtin_amdgcn_cvt_scalef32_pk_f32_fp4(buf[q_][0], 1.0f, 3) * wq_; \
        acc2[4] += __builtin_amdgcn_cvt_scalef32_pk_f32_fp4(buf[q_][1], 1.0f, 0) * wq_; acc2[5] += __builtin_amdgcn_cvt_scalef32_pk_f32_fp4(buf[q_][1], 1.0f, 1) * wq_; \
        acc2[6] += __builtin_amdgcn_cvt_scalef32_pk_f32_fp4(buf[q_][1], 1.0f, 2) * wq_; acc2[7] += __builtin_amdgcn_cvt_scalef32_pk_f32_fp4(buf[q_][1], 1.0f, 3) * wq_; \
        acc2[8] += __builtin_amdgcn_cvt_scalef32_pk_f32_fp4(buf[q_][2], 1.0f, 0) * wq_; acc2[9] += __builtin_amdgcn_cvt_scalef32_pk_f32_fp4(buf[q_][2], 1.0f, 1) * wq_; \
        acc2[10] += __builtin_amdgcn_cvt_scalef32_pk_f32_fp4(buf[q_][2], 1.0f, 2) * wq_; acc2[11] += __builtin_amdgcn_cvt_scalef32_pk_f32_fp4(buf[q_][2], 1.0f, 3) * wq_; \
        acc2[12] += __builtin_amdgcn_cvt_scalef32_pk_f32_fp4(buf[q_][3], 1.0f, 0) * wq_; acc2[13] += __builtin_amdgcn_cvt_scalef32_pk_f32_fp4(buf[q_][3], 1.0f, 1) * wq_; \
        acc2[14] += __builtin_amdgcn_cvt_scalef32_pk_f32_fp4(buf[q_][3], 1.0f, 2) * wq_; acc2[15] += __builtin_amdgcn_cvt_scalef32_pk_f32_fp4(buf[q_][3], 1.0f, 3) * wq_; \
        __builtin_amdgcn_sched_barrier(0); } } while (0)
template <int MODE>
__device__ __forceinline__ void peer_phase(const Args& a, LAS unsigned char* lds, int gw, int NGW, int tid, int lane) {
    const float* SU = (const float*)(a.ws + WS_U + 32 * MiB); const float* SV = (const float*)(a.ws + WS_V + 32 * MiB);
    LAS float* AMv = (LAS float*)lds; LAS float* SHv = AMv + NB * D;
    if (MODE == 1) {
#pragma unroll
    for (int i = 0; i < 8; ++i) { const int idx = (i * NTHREADS + tid) * 4; *(LAS f32x4*)(AMv + idx) = *(const f32x4*)((const float*)(a.ws + WS_AMSH) + idx); }
    }
    LAS float* FNl = SHv + NB * D; LAS unsigned short* G2l = (LAS unsigned short*)(FNl + D); LAS unsigned short* SVl = G2l + NB * D; LAS unsigned short* SUl = SVl + 16384;
    if (MODE == 1) {
    *(LAS f32x4*)(FNl + tid * 4) = *(const f32x4*)(a.in[21] + tid * 4);
#pragma unroll
    for (int i = 0; i < 4; ++i) { const int idx = (i * NTHREADS + tid) * 4; const f32x4 g4 = modf4((const long long*)(a.ws + WS_MOD) + (size_t)(idx >> 11) * MODW + 5 * D + (idx & (D - 1)));
        *(LAS u32x2*)(G2l + idx) = (u32x2){pk2(g4[0], g4[1]), pk2(g4[2], g4[3])}; }
#pragma unroll
    for (int i = 0; i < 8; ++i) { const int idx = (i * NTHREADS + tid) * 4; const f32x4 s4 = *(const f32x4*)(SV + idx), u4 = *(const f32x4*)(SU + idx);
        *(LAS u32x2*)(SVl + idx) = (u32x2){pk2(s4[0], s4[1]), pk2(s4[2], s4[3])}; *(LAS u32x2*)(SUl + idx) = (u32x2){pk2(u4[0], u4[1]), pk2(u4[2], u4[3])}; }
        return;
    }
    __syncthreads();
    const unsigned char* U6 = a.ws + WS_U; const unsigned char* V4 = a.ws + WS_V;
    const __amdgpu_buffer_rsrc_t rU = __builtin_amdgcn_make_buffer_rsrc((void*)U6, 0, 0x7fffffff, 0x00020000), rV = __builtin_amdgcn_make_buffer_rsrc((void*)V4, 0, 0x7fffffff, 0x00020000);
    const int* IDX = (const int*)(a.ws + WS_IDX); const float* Gt = (const float*)(a.ws + WS_G);
    const long long* MOD = (const long long*)(a.ws + WS_MOD); const float* fn = a.in[21]; float* xio = a.out; const bf16* X1 = (const bf16*)(a.ws + WS_X1);
    const int lo16 = lane * 16, lo8 = 1024 + lane * 8;
    u32x4 baA[8], bbA[8]; u32x2 baB[8], bbB[8];
    int id0 = 0, id1 = 0; float g0 = 0.f, g1 = 0.f; u32x2 xw_[8];
#pragma unroll
    for (int j = 0; j < 8; ++j) xw_[j] = (u32x2){0u, 0u};
    if (gw < M) {
#pragma unroll
        for (int j = 0; j < 8; ++j) xw_[j] = *(const u32x2*)(X1 + (size_t)gw * D + 256 * j + lane * 4);
        id0 = IDX[(size_t)gw * 128 + lane]; id1 = IDX[(size_t)gw * 128 + 64 + lane]; g0 = Gt[(size_t)gw * 128 + lane]; g1 = Gt[(size_t)gw * 128 + 64 + lane]; P8_LOAD(ba, sa, U6, SUl, 0); }
    for (int t = gw; t < M; t += NGW) {
        asm volatile("" : "+v"(lane));
        const bool b5 = (lane & 32) != 0, b4 = (lane & 16) != 0, b3 = (lane & 8) != 0;
        const int b = t >> 12;
        const int tn = t + NGW < M ? t + NGW : t;
        u32x4 va[8], vb[8];
        const float su0 = __uint_as_float((unsigned)SUl[id0] << 16), su1 = __uint_as_float((unsigned)SUl[id1] << 16), sv0 = __uint_as_float((unsigned)SVl[id0] << 16), sv1 = __uint_as_float((unsigned)SVl[id1] << 16);
        unsigned hvp[16];
        {
            f32x4 xv[8]; float ssx = 0.f;
#pragma unroll
            for (int j = 0; j < 8; ++j) { const u32x2 w = xw_[j];
                xv[j] = (f32x4){__uint_as_float(w.x << 16), __uint_as_float(w.x & 0xffff0000u), __uint_as_float(w.y << 16), __uint_as_float(w.y & 0xffff0000u)};
                ssx += (xv[j][0] * xv[j][0] + xv[j][1] * xv[j][1]) + (xv[j][2] * xv[j][2] + xv[j][3] * xv[j][3]); }
            const float rs = rsqrtf(wave_sum(ssx) * (1.f / D) + EPS);
#pragma unroll
            for (int j = 0; j < 8; ++j) { const f32x4 am = *(LAS const f32x4*)(AMv + b * D + 256 * j + lane * 4), sh = *(LAS const f32x4*)(SHv + b * D + 256 * j + lane * 4);
                const f32x4 y = xv[j] * rs * am + sh; hvp[2 * j] = pk2(y[0], y[1]); hvp[2 * j + 1] = pk2(y[2], y[3]); }
        }
        float w0 = 0.f, w1 = 0.f;
#pragma unroll 1
        for (int e0 = 0; e0 < 112; e0 += 16) {
            P8_LOAD(bb, sb, U6, SUl, e0 + 8);
            P8_UGROUP(ba, sa, e0);
            P8_LOAD(ba, sa, U6, SUl, e0 + 16);
            P8_UGROUP(bb, sb, e0 + 8);
        }
        P8_LOAD(bb, sb, U6, SUl, 120);
        P8_UGROUP(ba, sa, 112);
        P8_VLOAD(va, sa, 0);
        P8_UGROUP(bb, sb, 120);
        w0 *= sv0; w1 *= sv1;
        const int nid0 = IDX[(size_t)tn * 128 + lane], nid1 = IDX[(size_t)tn * 128 + 64 + lane]; const float ng0 = Gt[(size_t)tn * 128 + lane], ng1 = Gt[(size_t)tn * 128 + 64 + lane];
        u32x2 nxw[8];
#pragma unroll
        for (int j = 0; j < 8; ++j) nxw[j] = *(const u32x2*)(X1 + (size_t)tn * D + 256 * j + lane * 4);
        f32x2 acc2[16];
#pragma unroll
        for (int j = 0; j < 16; ++j) acc2[j] = (f32x2){0.f, 0.f};
#pragma unroll 1
        for (int e0 = 0; e0 < 112; e0 += 16) {
            P8_VLOAD(vb, sb, e0 + 8);
            P8_VGROUP(va, sa, e0);
            P8_VLOAD(va, sa, e0 + 16);
            P8_VGROUP(vb, sb, e0 + 8);
        }
        P8_VLOAD(vb, sb, 120);
        P8_VGROUP(va, sa, 112);
        P8_LOADX(ba, 0, nid0, nid1);
        P8_VGROUP(vb, sb, 120);
        float acc[32];
#pragma unroll
        for (int j = 0; j < 16; ++j) { acc[2 * j] = acc2[j].x; acc[2 * j + 1] = acc2[j].y; }
        float ss = 0.f;
#pragma unroll
        for (int j = 0; j < 8; ++j) { const int col = 256 * j + lane * 4; const u32x2 xw = xw_[j];
            const f32x4 x0 = {__uint_as_float(xw.x << 16), __uint_as_float(xw.x & 0xffff0000u), __uint_as_float(xw.y << 16), __uint_as_float(xw.y & 0xffff0000u)};
            const u32x2 gw_ = *(LAS const u32x2*)(G2l + b * D + col); const f32x4 ga = {__uint_as_float(gw_.x << 16), __uint_as_float(gw_.x & 0xffff0000u), __uint_as_float(gw_.y << 16), __uint_as_float(gw_.y & 0xffff0000u)};
#pragma unroll
            for (int k = 0; k < 4; ++k) { const float y = x0[k] + ga[k] * acc[4 * j + k]; acc[4 * j + k] = y; ss += y * y; } }
        ss = wave_sum(ss);
        const float rstd = rsqrtf(ss * (1.f / D) + EPS);
#pragma unroll
        for (int j = 0; j < 8; ++j) { const int col = 256 * j + lane * 4; const f32x4 f0 = *(LAS const f32x4*)(FNl + col);
            f32x4 o;
#pragma unroll
            for (int k = 0; k < 4; ++k) o[k] = acc[4 * j + k] * rstd * f0[k];
            __builtin_nontemporal_store(o, (f32x4*)(xio + (size_t)t * D + col)); }
        id0 = nid0; id1 = nid1; g0 = ng0; g1 = ng1;
#pragma unroll
        for (int j = 0; j < 8; ++j) xw_[j] = nxw[j];
    }
}


__global__ void __launch_bounds__(NTHREADS, 2) mega(Args a) {
    extern __shared__ __attribute__((aligned(16))) unsigned char lds_raw[];
    LAS unsigned char* lds = (LAS unsigned char*)lds_raw;
    const int tid = threadIdx.x, lane = tid & 63, wave = __builtin_amdgcn_readfirstlane(tid >> 6);
    const int G = gridDim.x, bx = blockIdx.x;
    const int vcu = (G % 8 == 0) ? (bx % 8) * (G / 8) + bx / 8 : bx;
    const int gw = vcu * NWAVES + wave, NGW = G * NWAVES;
    unsigned char* ws = a.ws;
    const long long* MOD = (const long long*)(ws + WS_MOD);
    bf16* H = (bf16*)(ws + WS_H); bf16* P = (bf16*)(ws + WS_P); bf16* AO = (bf16*)(ws + WS_AO); bf16* Qp = (bf16*)(ws + WS_QP);
    const int lo = a.ph_lo, hi = a.ph_hi;
    cooperative_groups::grid_group grid = cooperative_groups::this_grid();
#define IN(k) (lo <= (k) && (k) < hi)
#define SEAM(k) do { if (IN(k) && IN((k) + 1)) xcd_barrier(bar); } while (0)
    if (a.ph_lo < 0) grid.sync();
    volatile LAS unsigned* MISC = (volatile LAS unsigned*)(lds + LDS_BYTES - 256);
    if (tid < 32) MISC[tid] = 0u;
    __syncthreads();
    const XcdBarrier bar = xcd_barrier_post((unsigned*)(ws + WS_CTL), MISC + 8);
    if (IN(0)) { p0_prep(a, lds, gw, NGW, wave, lane); }
    SEAM(0);
    if (IN(1)) {
        norm_rows_batch(a.in[0], a.in[6], MOD, 0, D, (unsigned char*)H, gw, NGW, lane);
        norm_rows(a.in[2], MC, a.in[6], MOD, 0, D, 4, (unsigned char*)H + (size_t)M * D, gw, NGW, lane);
        p1_fold(a, lds, gw, NGW, tid, lane);
    }
    SEAM(1);
    if (IN(2)) {
        pg8::Gemm g{H, (const bf16*)(ws + WS_WIN), MT, PW, D / 2}; Order1 S{G, bx};
        EpiRope E{P, (const float*)(ws + WS_ROPE), ws};
        pg8::gemm_phase<EpiRope, Order1, true, true, true, 127, 122>(lds, g, S, E);
        if (a.tab_r0 < 2 * 16384 && bx >= 1192 % G) p0_tables<4>(a, a.tab_r0, 2 * 16384, (bx - 1192 % G) * NWAVES + wave, (G - 1192 % G) * NWAVES, lane);
    }
    SEAM(2);
    if (IN(3)) { attn_phase(a, lds, bx, G, tid, wave, lane); }
    SEAM(3);
    if (IN(4)) {
        pg8::Gemm g{AO, (const bf16*)(ws + WS_WOUT), M, D, D / 2}; pg8::StaticOrder S; S.init(M, D, G, bx);
        EpiRes E{a.in[0], MOD, (bf16*)(ws + WS_X1), (unsigned long long*)(ws + WS_ROWSS)};
        pg8::gemm_phase<EpiRes, pg8::StaticOrder, true, true, true, 127, 122>(lds, g, S, E);
    }
    SEAM(4);
    if (IN(6)) {
        pg8::Gemm g{(const bf16*)(ws + WS_X1), (const bf16*)(ws + WS_WQB), M, D, D}; Order6 S; S.S.init(M, D, G, bx);
        EpiQ2 E{Qp, (const unsigned long long*)(ws + WS_ROWSS), (const float*)(ws + WS_QBIAS)};
        pg8::gemm_phase<EpiQ2, Order6, true, true>(lds, g, S, E);
    }
    if (IN(6) && IN(7)) {
        asm volatile("s_waitcnt vmcnt(0)" ::: "memory");
        __builtin_amdgcn_fence(__ATOMIC_ACQUIRE, "agent");
        __syncthreads();
    }
    if (IN(7)) { topk_phase(a, lds, bx, G, tid, wave, lane); }
    if (IN(8)) { peer_phase<1>(a, lds, gw, NGW, tid, lane); }
    SEAM(7);
    if (IN(8)) { peer_phase<2>(a, lds, gw, NGW, tid, lane); }
#undef IN
#undef SEAM
}

extern "C" void kernel_launch(void* const* d_in, const int* in_sizes, int n_in, void* d_out, int out_size, void* d_ws, size_t ws_size, hipStream_t stream) {
    static int grid = 0;
    if (grid == 0) {
        int dev = 0, cus = 0, per_cu = 0;
        (void)hipGetDevice(&dev); (void)hipDeviceGetAttribute(&cus, hipDeviceAttributeMultiprocessorCount, dev);
        (void)hipFuncSetAttribute((const void*)mega, hipFuncAttributeMaxDynamicSharedMemorySize, LDS_BYTES);
        (void)hipOccupancyMaxActiveBlocksPerMultiprocessor(&per_cu, (const void*)mega, NTHREADS, LDS_BYTES);
        if (per_cu < 1) per_cu = 1;
        grid = (cus > 0 ? cus : 256) * per_cu;
    }
    if (ws_size < WS_END) { fprintf(stderr, "kernel_launch: workspace too small (%zu < %zu)\n", ws_size, (size_t)WS_END); return; }
    unsigned char* ws = (unsigned char*)d_ws;
    (void)hipMemsetAsync(ws + WS_CTL, 0, WS_MOD + 5 * MODW * 8, stream);
    Args a{};
    for (int i = 0; i < 22; ++i) a.in[i] = (const float*)d_in[i];
    a.out = (float*)d_out; a.ws = ws; a.ph_lo = 0; a.ph_hi = 9;
    a.tab_r0 = (1192 % grid) ? TAB_R0 : 2 * 16384;

    void* args[] = {&a};
    hipError_t e = hipLaunchCooperativeKernel((const void*)mega, dim3(grid), dim3(NTHREADS), args, LDS_BYTES, stream);
    if (e != hipSuccess) fprintf(stderr, "cooperative launch failed: %s (grid %d)\n", hipGetErrorString(e), grid);
}
```
